# Optimizing an MI355X kernel written in HIP

```python
import math
import jax, jax.numpy as jnp
from jax import lax
import numpy as np

D_MODEL = 1024
BATCH = 16
SEQ = 2048
DEPTH = 1

PLE_DIM = 256
D_RNN = 1280
RNN_BLOCKS = 10
RNN_BLOCK_W = D_RNN // RNN_BLOCKS
CONV_W = 4
LRU_C = 8.0
HEAD_DIM = 128
HEADS_PER_GROUP = 4
ATTN_PATTERNS = ((128, 1), (512, 4), (2048, 16))
N_GROUPS = len(ATTN_PATTERNS)
ATT_W = HEADS_PER_GROUP * HEAD_DIM
QKV_W = N_GROUPS * 3 * ATT_W
N_BRANCH = 2
N_IN = 2 * D_RNN + QKV_W + ATT_W + N_BRANCH * D_MODEL
ROPE_THETA = 10000.0
EPS = 1e-6

OFF_Z_RNN = D_RNN
OFF_QKV = 2 * D_RNN
OFF_Z_ATT = OFF_QKV + QKV_W
OFF_GATES = OFF_Z_ATT + ATT_W

kernel_name = "hybrid_rglru_dilated_attn_block"


def rms_norm(x, gain):
    xf = x.astype(jnp.float32)
    var = jnp.mean(xf * xf, axis=-1, keepdims=True)
    return (xf * lax.rsqrt(var + EPS) * gain.astype(jnp.float32)).astype(x.dtype)


def rope(t, cos, sin):
    t1, t2 = jnp.split(t.astype(jnp.float32), 2, axis=-1)
    c = cos[None, :, None, None, :]
    s = sin[None, :, None, None, :]
    return jnp.concatenate([t1 * c - t2 * s, t2 * c + t1 * s], axis=-1).astype(t.dtype)


def causal_depthwise_conv(x, w, b):
    s = x.shape[1]
    xp = jnp.pad(x, ((0, 0), (CONV_W - 1, 0), (0, 0)))
    y = b[None, None, :]
    for k in range(CONV_W):
        y = y + w[k][None, None, :] * xp[:, k:k + s]
    return y


def rg_lru(x, w_a, b_a, w_x, b_x, lam):
    b, s, _ = x.shape
    xf = x.astype(jnp.float32)
    xb = xf.reshape(b, s, RNN_BLOCKS, RNN_BLOCK_W)
    r = jax.nn.sigmoid(jnp.einsum('bsni,nij->bsnj', xb, w_a.astype(jnp.float32)).reshape(b, s, D_RNN) + b_a.astype(jnp.float32))
    i = jax.nn.sigmoid(jnp.einsum('bsni,nij->bsnj', xb, w_x.astype(jnp.float32)).reshape(b, s, D_RNN) + b_x.astype(jnp.float32))
    log_a = -LRU_C * r * jax.nn.softplus(-lam.astype(jnp.float32))[None, None, :]
    a = jnp.exp(log_a)
    mult = jnp.sqrt(-jnp.expm1(2.0 * log_a))
    mult = mult.at[:, 0].set(1.0)
    u = mult * (i * xf)

    def combine(left, right):
        a_l, u_l = left
        a_r, u_r = right
        return a_l * a_r, a_r * u_l + u_r

    _, h = lax.associative_scan(combine, (a, u), axis=1)
    return h.astype(x.dtype)


def dilated_window_attention(q, k, v, window, dilation):
    b, s, h, hd = q.shape
    blk = window // dilation
    sub_len = s // dilation
    n_blk = -(-sub_len // blk)
    padded = n_blk * blk

    def sub(t):
        return t.reshape(b, sub_len, dilation, h, hd)

    qb = jnp.pad(sub(q), ((0, 0), (0, padded - sub_len), (0, 0), (0, 0), (0, 0)))
    qb = qb.reshape(b, n_blk, blk, dilation, h, hd)

    def key_blocks(t):
        tp = jnp.pad(sub(t), ((0, 0), (blk, padded - sub_len), (0, 0), (0, 0), (0, 0)))
        prev = tp[:, :padded].reshape(b, n_blk, blk, dilation, h, hd)
        cur = tp[:, blk:].reshape(b, n_blk, blk, dilation, h, hd)
        return jnp.concatenate([prev, cur], axis=2)

    kb = key_blocks(k)
    vb = key_blocks(v)
    scores = jnp.einsum('bnqchd,bnkchd->bnchqk', qb, kb,
                        preferred_element_type=jnp.float32) * (hd ** -0.5)
    qi = jnp.arange(blk)[:, None]
    kj = jnp.arange(2 * blk)[None, :]
    dist = qi + blk - kj
    key_pos = jnp.arange(n_blk)[:, None, None] * blk + kj[None] - blk
    valid = ((dist >= 0) & (dist <= blk))[None] & (key_pos >= 0)
    scores = jnp.where(valid[None, :, None, None], scores, -jnp.inf)
    m = jnp.max(scores, axis=-1, keepdims=True)
    e = jnp.exp(scores - m)
    den = jnp.sum(e, axis=-1)
    o = jnp.einsum('bnchqk,bnkchd->bnqchd', e, vb.astype(jnp.float32))
    o = o / jnp.moveaxis(den, -1, 2)[..., None]
    lse = jnp.moveaxis(m[..., 0] + jnp.log(den), -1, 2)
    o = o.reshape(b, padded, dilation, h, hd)[:, :sub_len].reshape(b, s, h, hd)
    lse = lse.reshape(b, padded, dilation, h)[:, :sub_len].reshape(b, s, h)
    return o, lse


def setup_inputs(seed: int = 0) -> dict:
    key = jax.random.key(seed)
    ks = jax.random.split(key, 24)
    f32 = jnp.float32

    def nrm(k, shape, scale):
        return jax.random.normal(k, shape, f32) * scale

    u = jax.random.uniform(ks[9], (DEPTH, D_RNN), f32, minval=0.9, maxval=0.999)
    return {
        "x": nrm(ks[0], (BATCH, SEQ, D_MODEL), 1.0),
        "p": nrm(ks[1], (DEPTH, BATCH, SEQ, PLE_DIM), 1.0),
        "norm_mix": 1.0 + nrm(ks[2], (DEPTH, D_MODEL), 0.02),
        "w_in": nrm(ks[3], (DEPTH, D_MODEL, N_IN), D_MODEL ** -0.5),
        "b_in": nrm(ks[4], (DEPTH, N_IN), 0.01),
        "conv_w": nrm(ks[5], (DEPTH, CONV_W, D_RNN), CONV_W ** -0.5),
        "conv_b": nrm(ks[6], (DEPTH, D_RNN), 0.01),
        "w_rg_a": nrm(ks[7], (DEPTH, RNN_BLOCKS, RNN_BLOCK_W, RNN_BLOCK_W), RNN_BLOCK_W ** -0.5),
        "b_rg_a": nrm(ks[8], (DEPTH, D_RNN), 0.01),
        "w_rg_x": nrm(ks[10], (DEPTH, RNN_BLOCKS, RNN_BLOCK_W, RNN_BLOCK_W), RNN_BLOCK_W ** -0.5),
        "b_rg_x": nrm(ks[11], (DEPTH, D_RNN), 0.01),
        "lru_lambda": jnp.log(u) - jnp.log1p(-u),
        "q_norm": 1.0 + nrm(ks[12], (DEPTH, N_GROUPS, HEAD_DIM), 0.02),
        "k_norm": 1.0 + nrm(ks[13], (DEPTH, N_GROUPS, HEAD_DIM), 0.02),
        "w_o_rnn": nrm(ks[14], (DEPTH, D_RNN, D_MODEL), D_RNN ** -0.5),
        "w_o_att": nrm(ks[15], (DEPTH, ATT_W, D_MODEL), ATT_W ** -0.5),
        "w_out": nrm(ks[16], (DEPTH, D_MODEL, D_MODEL), D_MODEL ** -0.5),
        "norm_ple": 1.0 + nrm(ks[17], (DEPTH, D_MODEL), 0.02),
        "w_ple_gate": nrm(ks[18], (DEPTH, D_MODEL, D_MODEL), D_MODEL ** -0.5),
        "b_ple_gate": nrm(ks[19], (DEPTH, D_MODEL), 0.01),
        "w_ple": nrm(ks[20], (DEPTH, PLE_DIM, D_MODEL), PLE_DIM ** -0.5),
    }


def reference(x, p, norm_mix, w_in, b_in, conv_w, conv_b, w_rg_a, b_rg_a, w_rg_x, b_rg_x,
              lru_lambda, q_norm, k_norm, w_o_rnn, w_o_att, w_out, norm_ple, w_ple_gate,
              b_ple_gate, w_ple):
    b, s, _ = x.shape
    pos = jnp.arange(s, dtype=jnp.float32)
    inv_freq = ROPE_THETA ** (-jnp.arange(0, HEAD_DIM, 2, dtype=jnp.float32) / HEAD_DIM)
    ang = pos[:, None] * inv_freq[None, :]
    cos, sin = jnp.cos(ang), jnp.sin(ang)

    for layer in range(DEPTH):
        hn = rms_norm(x, norm_mix[layer])
        proj = jnp.einsum('bsd,dn->bsn', hn, w_in[layer]) + b_in[layer]
        x_rnn = proj[..., :OFF_Z_RNN]
        z_rnn = proj[..., OFF_Z_RNN:OFF_QKV]
        qkv = proj[..., OFF_QKV:OFF_Z_ATT]
        z_att = proj[..., OFF_Z_ATT:OFF_GATES]
        gates = jax.nn.sigmoid(proj[..., OFF_GATES:].reshape(b, s, N_BRANCH, D_MODEL))

        xc = causal_depthwise_conv(x_rnn, conv_w[layer], conv_b[layer])
        h_rnn = rg_lru(xc, w_rg_a[layer], b_rg_a[layer], w_rg_x[layer], b_rg_x[layer], lru_lambda[layer])
        y_rnn = h_rnn * jax.nn.silu(z_rnn)

        qkv = qkv.reshape(b, s, N_GROUPS, 3, HEADS_PER_GROUP, HEAD_DIM)
        q = rms_norm(qkv[:, :, :, 0], q_norm[layer][:, None, :])
        k = rms_norm(qkv[:, :, :, 1], k_norm[layer][:, None, :])
        v = qkv[:, :, :, 2]
        q = rope(q, cos, sin)
        k = rope(k, cos, sin)
        outs, lses = [], []
        for g, (window, dilation) in enumerate(ATTN_PATTERNS):
            o_g, lse_g = dilated_window_attention(q[:, :, g], k[:, :, g], v[:, :, g], window, dilation)
            outs.append(o_g)
            lses.append(lse_g)
        wts = jax.nn.softmax(jnp.stack(lses, axis=0), axis=0)
        att = jnp.sum(wts[..., None] * jnp.stack(outs, axis=0), axis=0)
        att = att.astype(x.dtype).reshape(b, s, ATT_W)
        y_att = att * jax.nn.silu(z_att)

        yr = jnp.einsum('bsc,cd->bsd', y_rnn, w_o_rnn[layer])
        ya = jnp.einsum('bsc,cd->bsd', y_att, w_o_att[layer])
        merged = gates[:, :, 0] * yr + gates[:, :, 1] * ya
        x = x + jnp.einsum('bsd,de->bse', merged, w_out[layer])

        pe = jnp.einsum('bsk,kd->bsd', p[layer], w_ple[layer])
        pg = jax.nn.sigmoid(jnp.einsum('bsd,de->bse', rms_norm(x, norm_ple[layer]), w_ple_gate[layer]) + b_ple_gate[layer])
        x = x + pg * pe
    return x
```

```cpp
#include <hip/hip_runtime.h>
#include <hip/hip_cooperative_groups.h>
#include <cstdio>
namespace cg = cooperative_groups;

#define LAS __attribute__((address_space(3)))
typedef unsigned short bf16_t;
typedef short bf16x8 __attribute__((ext_vector_type(8)));
typedef float f32x4 __attribute__((ext_vector_type(4)));
typedef unsigned u32x4 __attribute__((ext_vector_type(4)));
typedef unsigned u32x2 __attribute__((ext_vector_type(2)));

constexpr int MROWS = 32768, SEQ = 2048, DM = 1024, DRNN = 1280, NIN = 9728, PLE = 256, QKVW = 4608, ATTW = 512;
constexpr int NA = 6144;
constexpr int NB = 3584;
constexpr float EPS = 1e-6f;

constexpr size_t al256(size_t x) { return (x + 255) & ~(size_t)255; }
constexpr size_t OFF_WIN = 0;
constexpr size_t OFF_WR = al256(OFF_WIN + (size_t)NIN * DM * 2);
constexpr size_t OFF_WA = al256(OFF_WR + (size_t)DM * DRNN * 2);
constexpr size_t OFF_WOUT = al256(OFF_WA + (size_t)DM * ATTW * 2);
constexpr size_t OFF_WPG = al256(OFF_WOUT + (size_t)DM * DM * 2);
constexpr size_t OFF_WPE = al256(OFF_WPG + (size_t)DM * DM * 2);
constexpr size_t OFF_WGA = al256(OFF_WPE + (size_t)DM * PLE * 2);
constexpr size_t OFF_WGX = al256(OFF_WGA + (size_t)10 * 128 * 128 * 2);
constexpr size_t OFF_BIN = al256(OFF_WGX + (size_t)10 * 128 * 128 * 2);
constexpr size_t OFF_ROPE = al256(OFF_BIN + (size_t)NIN * 4);
constexpr size_t OFF_TOT = al256(OFF_ROPE + (size_t)2 * SEQ * 64 * 4);
constexpr size_t OFF_LSE = al256(OFF_TOT + (size_t)16 * 16 * DRNN * 2 * 4);
constexpr size_t OFF_SSQ = al256(OFF_LSE + (size_t)3 * MROWS * 4 * 4);
constexpr size_t OFF_CTR = al256(OFF_SSQ + (size_t)MROWS * 16 * 4);
constexpr size_t OFF_BAR = al256(OFF_CTR + 256);
constexpr size_t OFF_HN = al256(OFF_BAR + 3456 * 4);
constexpr size_t OFF_PB = al256(OFF_HN + (size_t)MROWS * DM * 2);
constexpr size_t OFF_XR = al256(OFF_PB + (size_t)MROWS * PLE * 2);
constexpr size_t OFF_R = al256(OFF_XR + (size_t)MROWS * DRNN * 2);
constexpr size_t OFF_ZR = OFF_R;
constexpr size_t OFF_ZA = al256(OFF_ZR + (size_t)MROWS * DRNN * 2);
constexpr size_t OFF_G = al256(OFF_ZA + (size_t)MROWS * ATTW * 2);
constexpr size_t OFF_GX = al256(OFF_R + (size_t)MROWS * QKVW * 2);
constexpr size_t WS_END = al256(OFF_GX + (size_t)MROWS * 256 * 2);
static_assert(OFF_G + (size_t)MROWS * 2048 * 2 <= WS_END, "region R too small");
static_assert(WS_END <= (size_t)536870912, "workspace over 512 MiB");

constexpr int GAIN_OFF = 4 * 128 * 272 + 1536;
constexpr int LDS_BYTES = 4 * 128 * 272 + 1536 + 3072 + 16;
constexpr int KS_STRIDE = 272, VT_STRIDE = 528, XC_STRIDE = 272;
constexpr int VT_OFF = 256 * KS_STRIDE;

struct Params {
    const float *x, *p, *norm_mix, *w_in, *b_in, *conv_w, *conv_b, *w_rg_a, *b_rg_a, *w_rg_x, *b_rg_x, *lam, *q_norm, *k_norm, *w_o_rnn, *w_o_att, *w_out, *norm_ple, *w_ple_gate, *b_ple_gate, *w_ple;
    float* out; unsigned char* ws;
};

__device__ __forceinline__ unsigned pk2(float lo, float hi) { unsigned r; asm volatile("v_cvt_pk_bf16_f32 %0, %1, %2" : "=v"(r) : "v"(lo), "v"(hi)); return r; }
__device__ __forceinline__ float bflo(unsigned w) { return __uint_as_float(w << 16); }
__device__ __forceinline__ float bfhi(unsigned w) { return __uint_as_float(w & 0xffff0000u); }
__device__ __forceinline__ float bf2f(bf16_t b) { return __uint_as_float(((unsigned)b) << 16); }
__device__ __forceinline__ float wave_sum(float v) {
#pragma unroll
    for (int o = 1; o < 64; o <<= 1) v += __shfl_xor(v, o);
    return v;
}
__device__ __forceinline__ float sigmoidf_(float v) { return __builtin_amdgcn_rcpf(1.0f + __expf(-v)); }
__device__ __forceinline__ float siluf_(float v) { return v * __builtin_amdgcn_rcpf(1.0f + __expf(-v)); }
#define LDS_WAIT() asm volatile("s_waitcnt lgkmcnt(0)" ::: "memory")

namespace pg8 {
constexpr int BM = 256, BK = 64, HALF = 128, HTB = HALF * BK * 2, STAGE_BYTES = 8 * HTB, NXCD = 8, WGM = 8;
__host__ __device__ __forceinline__ int lds_byte(int r, int c) { const int st = (r >> 4) * 2 + (c >> 5), rr = r & 15, cc = c & 31, ob = rr * 64 + cc * 2; return st * 1024 + (ob ^ (((ob >> 9) & 1) << 5)); }
__host__ __device__ __forceinline__ void stage_rc(int b, int& R, int& C) { const int st = b / 1024, sb = b % 1024, swz = sb ^ (((sb >> 9) & 1) << 5); R = (st >> 1) * 16 + swz / 64; C = (st & 1) * 32 + (swz % 64) / 2; }
__host__ __device__ __forceinline__ int perm32(int rho) { const int n = rho >> 4, i = rho & 15; return 8 * (i >> 2) + 4 * n + (i & 3); }
struct Unit { int pm, pn; };
struct Gemm { const bf16_t* A; const bf16_t* Bt; int M, N, K; };
struct StaticOrder {
    int nM, nN, nwg, G, c;
    __device__ void init(int M, int N, int G_, int c_) { nM = M / BM; nN = N / BM; nwg = nM * nN; G = G_; c = c_; }
    __device__ bool next(int i, Unit& u) const {
        const long L = (long)i * G + c; if (L >= nwg) return false;
        int wgid = (int)L; { const int q = nwg / NXCD, r = nwg % NXCD, xcd = wgid % NXCD, off = wgid / NXCD; wgid = (xcd < r ? xcd * (q + 1) : r * (q + 1) + (xcd - r) * q) + off; }
        const int nig = WGM * nN, gid = wgid / nig, fm = gid * WGM, gsz = (nM - fm) < WGM ? (nM - fm) : WGM;
        u.pm = fm + ((wgid % nig) % gsz); u.pn = (wgid % nig) / gsz; return true;
    }
};

template <class Epi>
__device__ __forceinline__ void gemm_phase(LAS unsigned char* lds, const Gemm g, const StaticOrder& S, const Epi& E) {
    int tid = threadIdx.x; asm volatile("" : "+v"(tid));
    const int wid = __builtin_amdgcn_readfirstlane(tid >> 6), lane = tid & 63, wr = wid >> 2, wc = wid & 3, fr = lane & 15, fq = lane >> 4;
    int K = g.K; asm volatile("" : "+s"(K)); const int nt = K / BK;
    unsigned voffA[2], voffB[2];
#pragma unroll
    for (int i = 0; i < 2; ++i) { int R, C; stage_rc(tid * 16 + i * 8192, R, C); const int Rb = Epi::PERM ? ((R & ~31) + perm32(R & 31)) : R;
        voffA[i] = (unsigned)(R * K + C) * 2u; voffB[i] = (unsigned)(Rb * K + C) * 2u; }
    const size_t kstep = (size_t)(BK * 2);
    const size_t hstep = (size_t)HALF * K * 2;
    const size_t tstep = 2 * hstep;
    const unsigned ldsw = (unsigned)wid * 1024u;
    const int aoff = lds_byte(wr * 64 + fr, fq * 8), boff = lds_byte(wc * 32 + fr, fq * 8);
#define PG8_SA(b, h) (((b) * 2 + (h)) * HTB)
#define PG8_SB(b, h) ((4 + (b) * 2 + (h)) * HTB)
#define PG8_STAGE(bufoff, gbase, voff) do { _Pragma("unroll") for (int _i = 0; _i < 2; ++_i) \
        __builtin_amdgcn_global_load_lds((const unsigned*)((const char*)(gbase) + (voff)[_i]), (LAS unsigned*)(lds + (bufoff) + ldsw + _i * 8192), 16, 0, 0); } while (0)
#define PG8_LDA(dst, b, h) do { _Pragma("unroll") for (int m = 0; m < 4; ++m) _Pragma("unroll") for (int k = 0; k < 2; ++k) dst[m][k] = *(const LAS bf16x8*)(lds + PG8_SA(b, h) + aoff + m * 2048 + k * 1024); } while (0)
#define PG8_LDB(dst, b, h) do { _Pragma("unroll") for (int n = 0; n < 2; ++n) _Pragma("unroll") for (int k = 0; k < 2; ++k) dst[n][k] = *(const LAS bf16x8*)(lds + PG8_SB(b, h) + boff + n * 2048 + k * 1024); } while (0)
#define PG8_MMA(ai, bj, At, Bt) do { __builtin_amdgcn_s_setprio(1); _Pragma("unroll") for (int m = 0; m < 4; ++m) _Pragma("unroll") for (int n = 0; n < 2; ++n) _Pragma("unroll") for (int k = 0; k < 2; ++k) \
        acc[ai][bj][m][n] = __builtin_amdgcn_mfma_f32_16x16x32_bf16(Bt[n][k], At[m][k], acc[ai][bj][m][n], 0, 0, 0); __builtin_amdgcn_s_setprio(0); } while (0)
#define PG8_WAIT_V(n) asm volatile("s_waitcnt vmcnt(" #n ")" ::: "memory")
#define PG8_WAIT_L(n) asm volatile("s_waitcnt lgkmcnt(" #n ")" ::: "memory")
#define PG8_BAR __builtin_amdgcn_s_barrier()
#define PG8_SCHED __builtin_amdgcn_sched_barrier(0)
    Unit cur, nxt; int ui = 0;
    if (!S.next(0, cur)) return;
    f32x4 acc[2][2][4][2];
#pragma unroll
    for (int a = 0; a < 2; ++a)
#pragma unroll
        for (int b = 0; b < 2; ++b)
#pragma unroll
            for (int m = 0; m < 4; ++m)
#pragma unroll
                for (int n = 0; n < 2; ++n) acc[a][b][m][n] = (f32x4){0.f, 0.f, 0.f, 0.f};
    bf16x8 At[4][2], B0[2][2], B1[2][2];
    f32x4 bvp[2][2];
#pragma unroll
    for (int bj = 0; bj < 2; ++bj)
#pragma unroll
        for (int n = 0; n < 2; ++n) bvp[bj][n] = (f32x4){0.f, 0.f, 0.f, 0.f};
    const char* cA = (const char*)g.A + (size_t)cur.pm * tstep; const char* cB = (const char*)g.Bt + (size_t)cur.pn * tstep;
    PG8_STAGE(PG8_SB(0, 0), cB, voffB); PG8_STAGE(PG8_SA(0, 0), cA, voffA); PG8_STAGE(PG8_SB(0, 1), cB + hstep, voffB); PG8_STAGE(PG8_SA(0, 1), cA + hstep, voffA);
    if (wr == 1) PG8_BAR;
    PG8_WAIT_V(4); PG8_BAR;
    PG8_STAGE(PG8_SB(1, 0), cB + kstep, voffB); PG8_STAGE(PG8_SA(1, 0), cA + kstep, voffA); PG8_STAGE(PG8_SB(1, 1), cB + hstep + kstep, voffB);
    PG8_WAIT_V(6); PG8_BAR;
    for (;;) {
        const bool has_next = S.next(ui + 1, nxt);
        const char* nA = has_next ? (const char*)g.A + (size_t)nxt.pm * tstep : cA; const char* nB = has_next ? (const char*)g.Bt + (size_t)nxt.pn * tstep : cB;
        for (int t = 0; t < nt; t += 2) {
            if constexpr (Epi::MID_T > 0) { if (t == Epi::MID_T) E.mid(acc, cur, wr, wc, fr, fq); }
            const bool last = (t == nt - 2);
            if constexpr (Epi::HAS_BIAS) { if (last) { const float* bp = E.bias + cur.pn * 256 + wc * 32 + 8 * fq;
#pragma unroll
                for (int bj = 0; bj < 2; ++bj)
#pragma unroll
                    for (int n = 0; n < 2; ++n) bvp[bj][n] = *(const f32x4*)(bp + bj * 128 + 4 * n); } }
            const char* a1 = cA + (size_t)(t + 1) * kstep;
            const char* a2 = last ? nA : cA + (size_t)(t + 2) * kstep; const char* b2 = last ? nB : cB + (size_t)(t + 2) * kstep;
            const char* a3 = a2 + kstep; const char* b3 = b2 + kstep;
            PG8_LDB(B0, 0, 0); PG8_SCHED; PG8_LDA(At, 0, 0); PG8_STAGE(PG8_SA(1, 1), a1 + hstep, voffA);
            PG8_WAIT_L(8); PG8_BAR; PG8_WAIT_L(0); PG8_MMA(0, 0, At, B0); PG8_BAR; PG8_SCHED;
            PG8_LDB(B1, 0, 1); PG8_STAGE(PG8_SB(0, 0), b2, voffB);
            PG8_BAR; PG8_WAIT_L(0); PG8_MMA(0, 1, At, B1); PG8_BAR;
            PG8_LDA(At, 0, 1); PG8_STAGE(PG8_SA(0, 0), a2, voffA);
            PG8_BAR; PG8_WAIT_L(0); PG8_MMA(1, 0, At, B0); PG8_BAR; PG8_SCHED;
            PG8_STAGE(PG8_SB(0, 1), b2 + hstep, voffB);
            PG8_WAIT_V(6); PG8_BAR; PG8_MMA(1, 1, At, B1); PG8_BAR;
            PG8_LDB(B0, 1, 0); PG8_SCHED; PG8_LDA(At, 1, 0); PG8_STAGE(PG8_SA(0, 1), a2 + hstep, voffA);
            PG8_WAIT_L(8); PG8_BAR; PG8_WAIT_L(0); PG8_MMA(0, 0, At, B0); PG8_BAR; PG8_SCHED;
            PG8_LDB(B1, 1, 1); PG8_STAGE(PG8_SB(1, 0), b3, voffB);
            PG8_BAR; PG8_WAIT_L(0); PG8_MMA(0, 1, At, B1); PG8_BAR;
            PG8_LDA(At, 1, 1); PG8_STAGE(PG8_SA(1, 0), a3, voffA);
            PG8_BAR; PG8_WAIT_L(0); PG8_MMA(1, 0, At, B0); PG8_BAR; PG8_SCHED;
            PG8_STAGE(PG8_SB(1, 1), b3 + hstep, voffB);
            PG8_WAIT_V(6); PG8_BAR; PG8_MMA(1, 1, At, B1); PG8_BAR;
        }
        if constexpr (Epi::HAS_BIAS) E(acc, cur, wr, wc, fr, fq, bvp); else E(acc, cur, wr, wc, fr, fq);
        if (!has_next) break;
#pragma unroll
        for (int a = 0; a < 2; ++a)
#pragma unroll
            for (int b = 0; b < 2; ++b)
#pragma unroll
                for (int m = 0; m < 4; ++m)
#pragma unroll
                    for (int n = 0; n < 2; ++n) acc[a][b][m][n] = (f32x4){0.f, 0.f, 0.f, 0.f};
        cur = nxt; cA = nA; cB = nB; ++ui;
    }
    PG8_WAIT_V(0);
    if (wr == 0) PG8_BAR;
    PG8_BAR;
#undef PG8_SA
#undef PG8_SB
#undef PG8_STAGE
#undef PG8_LDA
#undef PG8_LDB
#undef PG8_MMA
#undef PG8_WAIT_V
#undef PG8_WAIT_L
#undef PG8_BAR
#undef PG8_SCHED
}
}
using pg8::Unit;

template <int WHICH> struct EpiProj {
    static constexpr bool PERM = true; static constexpr int MID_T = 0; static constexpr bool HAS_BIAS = true;
    const float* bias;
    unsigned char* ws; const void* ogp;
    __device__ __forceinline__ void operator()(const f32x4 (&acc)[2][2][4][2], const Unit& u, int wr, int wc, int fr, int fq, const f32x4 (&bv)[2][2]) const {
        constexpr int pnb0 = 5, pnb1 = WHICH == 0 ? 23 : 7;
        const int t = u.pn < pnb0 ? 0 : (u.pn < pnb1 ? 1 : 2);
        const size_t off = WHICH == 0 ? (t == 0 ? OFF_XR : (t == 1 ? OFF_R : OFF_GX)) : (t == 2 ? OFF_G : OFF_ZR);
        const int ld = WHICH == 0 ? (t == 0 ? DRNN : (t == 1 ? QKVW : 256)) : (t == 2 ? 2048 : 1792);
        const int cbase = WHICH == 1 ? (t == 1 ? DRNN : (t == 2 ? 256 : 0)) : 0;
        bf16_t* base = (bf16_t*)(ws + off);
        const int colt = (u.pn - (t == 0 ? 0 : (t == 1 ? pnb0 : pnb1))) * 256;
        const int row0 = u.pm * 256 + wr * 64 + fr, col0 = colt + wc * 32 + 8 * fq, bcol0 = u.pn * 256 + wc * 32 + 8 * fq;
        const bool sig = (WHICH == 0 && t == 2) || (WHICH == 1 && t == 2);
        if (WHICH == 1 && t == 0) {
#pragma unroll
            for (int ai = 0; ai < 2; ++ai) {
                u32x4 hh[4][2];
#pragma unroll
                for (int m = 0; m < 4; ++m)
#pragma unroll
                    for (int bj = 0; bj < 2; ++bj) hh[m][bj] = *(const u32x4*)((const bf16_t*)(ws + OFF_XR) + (size_t)(row0 + ai * 128 + m * 16) * DRNN + col0 + bj * 128);
#pragma unroll
                for (int m = 0; m < 4; ++m) { bf16_t* rowp = base + (size_t)(row0 + ai * 128 + m * 16) * ld + col0 + cbase;
#pragma unroll
                    for (int bj = 0; bj < 2; ++bj) { const f32x4 v0 = acc[ai][bj][m][0] + bv[bj][0], v1 = acc[ai][bj][m][1] + bv[bj][1]; const u32x4 q = hh[m][bj];
                        u32x4 w; w.x = pk2(siluf_(v0[0]) * bflo(q.x), siluf_(v0[1]) * bfhi(q.x)); w.y = pk2(siluf_(v0[2]) * bflo(q.y), siluf_(v0[3]) * bfhi(q.y));
                        w.z = pk2(siluf_(v1[0]) * bflo(q.z), siluf_(v1[1]) * bfhi(q.z)); w.w = pk2(siluf_(v1[2]) * bflo(q.w), siluf_(v1[3]) * bfhi(q.w));
                        *(u32x4*)(rowp + bj * 128) = w; } }
                asm volatile("" ::: "memory"); }
            return; }
#pragma unroll
        for (int ai = 0; ai < 2; ++ai)
#pragma unroll
        for (int mh = 0; mh < 2; ++mh) {
            f32x4 mul[2][2][2];
            if (WHICH == 1 && t == 1) {
                const float* LSE = (const float*)(ws + OFF_LSE); const bf16_t* OG = (const bf16_t*)ogp;
                u32x4 og[2][2][3]; float ls[2][2][3];
#pragma unroll
                for (int mm = 0; mm < 2; ++mm)
#pragma unroll
                    for (int bj = 0; bj < 2; ++bj) { const size_t row = (size_t)(row0 + ai * 128 + (2 * mh + mm) * 16); const int col = col0 + bj * 128, hd = col >> 7;
#pragma unroll
                        for (int gq = 0; gq < 3; ++gq) { og[mm][bj][gq] = *(const u32x4*)(OG + ((size_t)gq * MROWS + row) * ATTW + col); ls[mm][bj][gq] = LSE[((size_t)gq * MROWS + row) * 4 + hd]; } }
#pragma unroll
                for (int mm = 0; mm < 2; ++mm)
#pragma unroll
                    for (int bj = 0; bj < 2; ++bj) { const float l0 = ls[mm][bj][0], l1 = ls[mm][bj][1], l2 = ls[mm][bj][2];
                        const float mxl = fmaxf(l0, fmaxf(l1, l2)); float w0 = __expf(l0 - mxl), w1 = __expf(l1 - mxl), w2 = __expf(l2 - mxl); const float inv = __builtin_amdgcn_rcpf(w0 + w1 + w2); w0 *= inv; w1 *= inv; w2 *= inv;
                        const u32x4 o0 = og[mm][bj][0], o1 = og[mm][bj][1], o2 = og[mm][bj][2];
                        mul[mm][bj][0] = (f32x4){w0 * bflo(o0.x) + w1 * bflo(o1.x) + w2 * bflo(o2.x), w0 * bfhi(o0.x) + w1 * bfhi(o1.x) + w2 * bfhi(o2.x), w0 * bflo(o0.y) + w1 * bflo(o1.y) + w2 * bflo(o2.y), w0 * bfhi(o0.y) + w1 * bfhi(o1.y) + w2 * bfhi(o2.y)};
                        mul[mm][bj][1] = (f32x4){w0 * bflo(o0.z) + w1 * bflo(o1.z) + w2 * bflo(o2.z), w0 * bfhi(o0.z) + w1 * bfhi(o1.z) + w2 * bfhi(o2.z), w0 * bflo(o0.w) + w1 * bflo(o1.w) + w2 * bflo(o2.w), w0 * bfhi(o0.w) + w1 * bfhi(o1.w) + w2 * bfhi(o2.w)}; } }
            if (sig) {
                const int gj = WHICH == 0 ? 0 : u.pn - 6;
                bf16_t* Rb = WHICH == 0 ? (bf16_t*)(ws + OFF_GX) : (bf16_t*)(ws + OFF_G); const int ldg = WHICH == 0 ? 128 : 1024;
                bf16_t* Gb = Rb + (size_t)MROWS * ldg; const int gcol = (WHICH == 0 ? 0 : gj * 128) + wc * 32 + 8 * fq;
#pragma unroll
                for (int mm = 0; mm < 2; ++mm) { const int m = 2 * mh + mm; const size_t row = (size_t)(row0 + ai * 128 + m * 16);
                    u32x4 wr_, wg_; float rr[8], gg[8];
#pragma unroll
                    for (int n = 0; n < 2; ++n)
#pragma unroll
                        for (int j = 0; j < 4; ++j) { const float a0 = acc[ai][0][m][n][j] + bv[0][n][j], a1 = acc[ai][1][m][n][j] + bv[1][n][j];
                            const float d0 = 1.0f + __expf(-a0), d1 = 1.0f + __expf(-a1);
                            gg[4 * n + j] = __builtin_amdgcn_rcpf(d1); rr[4 * n + j] = d1 * __builtin_amdgcn_rcpf(d0); }
                    wr_.x = pk2(rr[0], rr[1]); wr_.y = pk2(rr[2], rr[3]); wr_.z = pk2(rr[4], rr[5]); wr_.w = pk2(rr[6], rr[7]);
                    wg_.x = pk2(gg[0], gg[1]); wg_.y = pk2(gg[2], gg[3]); wg_.z = pk2(gg[4], gg[5]); wg_.w = pk2(gg[6], gg[7]);
                    *(u32x4*)(Rb + row * ldg + gcol) = wr_; *(u32x4*)(Gb + row * ldg + gcol) = wg_; }
                continue; }
#pragma unroll
            for (int mm = 0; mm < 2; ++mm) { const int m = 2 * mh + mm; bf16_t* rowp = base + (size_t)(row0 + ai * 128 + m * 16) * ld + col0 + cbase;
#pragma unroll
                for (int bj = 0; bj < 2; ++bj) { f32x4 v0 = acc[ai][bj][m][0] + bv[bj][0], v1 = acc[ai][bj][m][1] + bv[bj][1];
                    if (WHICH == 1) {
#pragma unroll
                        for (int j = 0; j < 4; ++j) { v0[j] = siluf_(v0[j]) * mul[mm][bj][0][j]; v1[j] = siluf_(v1[j]) * mul[mm][bj][1][j]; } }
                    u32x4 w; w.x = pk2(v0[0], v0[1]); w.y = pk2(v0[2], v0[3]); w.z = pk2(v1[0], v1[1]); w.w = pk2(v1[2], v1[3]);
                    *(u32x4*)(rowp + bj * 128) = w; } }
            if (WHICH == 1) asm volatile("" ::: "memory"); }
    }
};
struct EpiMergeFused {
    static constexpr bool PERM = true; static constexpr int MID_T = 20; static constexpr bool HAS_BIAS = false;
    const bf16_t* G; bf16_t* MG; const bf16_t* GX;
    __device__ __forceinline__ void mid(f32x4 (&acc)[2][2][4][2], const Unit& u, int wr, int wc, int fr, int fq) const {
        int frx = fr, fqx = fq; asm volatile("" : "+v"(frx), "+v"(fqx));
        const int row0 = u.pm * 256 + wr * 64 + frx, col0 = u.pn * 256 + wc * 32 + 8 * fqx;
        u32x4 rq[2][4][2];
#pragma unroll
        for (int ai = 0; ai < 2; ++ai)
#pragma unroll
            for (int m = 0; m < 4; ++m)
#pragma unroll
                for (int bj = 0; bj < 2; ++bj) { const size_t row = (size_t)(row0 + ai * 128 + m * 16); const int col = col0 + bj * 128;
                    rq[ai][m][bj] = *(const u32x4*)((bj == 0 && u.pn == 0) ? GX + row * 128 + col : G + row * 1024 + col); }
#pragma unroll
        for (int ai = 0; ai < 2; ++ai)
#pragma unroll
            for (int m = 0; m < 4; ++m)
#pragma unroll
                for (int bj = 0; bj < 2; ++bj) { const u32x4 a = rq[ai][m][bj];
                    acc[ai][bj][m][0] *= (f32x4){bflo(a.x), bfhi(a.x), bflo(a.y), bfhi(a.y)}; acc[ai][bj][m][1] *= (f32x4){bflo(a.z), bfhi(a.z), bflo(a.w), bfhi(a.w)}; }
        asm volatile("" ::: "memory");
    }
    __device__ __forceinline__ void operator()(const f32x4 (&acc)[2][2][4][2], const Unit& u, int wr, int wc, int fr, int fq) const {
        const int row0 = u.pm * 256 + wr * 64 + fr, col0 = u.pn * 256 + wc * 32 + 8 * fq;
        const bf16_t* G1 = G + (size_t)MROWS * 1024; const bf16_t* GX1 = GX + (size_t)MROWS * 128;
        u32x4 gg[2][4][2];
#pragma unroll
        for (int ai = 0; ai < 2; ++ai)
#pragma unroll
            for (int m = 0; m < 4; ++m)
#pragma unroll
                for (int bj = 0; bj < 2; ++bj) { const size_t row = (size_t)(row0 + ai * 128 + m * 16); const int col = col0 + bj * 128;
                    gg[ai][m][bj] = *(const u32x4*)((bj == 0 && u.pn == 0) ? GX1 + row * 128 + col : G1 + row * 1024 + col); }
#pragma unroll
        for (int ai = 0; ai < 2; ++ai)
#pragma unroll
            for (int m = 0; m < 4; ++m) { const size_t row = (size_t)(row0 + ai * 128 + m * 16);
#pragma unroll
                for (int bj = 0; bj < 2; ++bj) { const int col = col0 + bj * 128; const u32x4 q = gg[ai][m][bj];
                    const f32x4 a0 = acc[ai][bj][m][0], a1 = acc[ai][bj][m][1];
                    u32x4 w; w.x = pk2(a0[0] * bflo(q.x), a0[1] * bfhi(q.x)); w.y = pk2(a0[2] * bflo(q.y), a0[3] * bfhi(q.y));
                    w.z = pk2(a1[0] * bflo(q.z), a1[1] * bfhi(q.z)); w.w = pk2(a1[2] * bflo(q.w), a1[3] * bfhi(q.w));
                    *(u32x4*)(MG + row * 1024 + col) = w; } }
    }
};
struct EpiX1 {
    static constexpr bool PERM = true; static constexpr int MID_T = 0; static constexpr bool HAS_BIAS = false;
    const float* x; float* X1; bf16_t* X1B; float* SSQ;
    __device__ __forceinline__ void operator()(const f32x4 (&acc)[2][2][4][2], const Unit& u, int wr, int wc, int fr, int fq) const {
        const int row0 = u.pm * 256 + wr * 64 + fr, col0 = u.pn * 256 + wc * 32 + 8 * fq;
#pragma unroll
        for (int ai = 0; ai < 2; ++ai) {
            f32x4 xv[4][2][2];
#pragma unroll
            for (int m = 0; m < 4; ++m)
#pragma unroll
                for (int bj = 0; bj < 2; ++bj) { const size_t o = (size_t)(row0 + ai * 128 + m * 16) * 1024 + col0 + bj * 128; xv[m][bj][0] = *(const f32x4*)(x + o); xv[m][bj][1] = *(const f32x4*)(x + o + 4); }
#pragma unroll
            for (int m = 0; m < 4; ++m) { const size_t row = (size_t)(row0 + ai * 128 + m * 16); float ss = 0.f;
#pragma unroll
                for (int bj = 0; bj < 2; ++bj) { const size_t o = row * 1024 + col0 + bj * 128;
                    const f32x4 v0 = xv[m][bj][0] + acc[ai][bj][m][0], v1 = xv[m][bj][1] + acc[ai][bj][m][1];
                    u32x4 w; w.x = pk2(v0[0], v0[1]); w.y = pk2(v0[2], v0[3]); w.z = pk2(v1[0], v1[1]); w.w = pk2(v1[2], v1[3]);
                    *(u32x4*)(X1B + o) = w;
                    ss += (v0[0] * v0[0] + v0[1] * v0[1]) + (v0[2] * v0[2] + v0[3] * v0[3]) + (v1[0] * v1[0] + v1[1] * v1[1]) + (v1[2] * v1[2] + v1[3] * v1[3]); }
                ss += __shfl_xor(ss, 16); ss += __shfl_xor(ss, 32);
                if (fq == 0) SSQ[row * 16 + u.pn * 4 + wc] = ss; }
            asm volatile("" ::: "memory"); }
    }
};
struct EpiPe {
    static constexpr bool PERM = true; static constexpr int MID_T = 0; static constexpr bool HAS_BIAS = false;
    bf16_t* PE; const float* SSQ; float* RSTD;
    __device__ __forceinline__ void operator()(const f32x4 (&acc)[2][2][4][2], const Unit& u, int wr, int wc, int fr, int fq) const {
        const int row0 = u.pm * 256 + wr * 64 + fr, col0 = u.pn * 256 + wc * 32 + 8 * fq;
#pragma unroll
        for (int ai = 0; ai < 2; ++ai) {
            f32x4 sv[4][4];
#pragma unroll
            for (int m = 0; m < 4; ++m)
#pragma unroll
                for (int q = 0; q < 4; ++q) sv[m][q] = *(const f32x4*)(SSQ + (size_t)(row0 + ai * 128 + m * 16) * 16 + 4 * q);
#pragma unroll
            for (int m = 0; m < 4; ++m) { const f32x4 st = (sv[m][0] + sv[m][1]) + (sv[m][2] + sv[m][3]);
                RSTD[row0 + ai * 128 + m * 16] = rsqrtf(((st[0] + st[1]) + (st[2] + st[3])) * (1.0f / 1024.0f) + EPS); } }
#pragma unroll
        for (int ai = 0; ai < 2; ++ai)
#pragma unroll
            for (int m = 0; m < 4; ++m) { const size_t row = (size_t)(row0 + ai * 128 + m * 16);
#pragma unroll
                for (int bj = 0; bj < 2; ++bj) { const size_t o = row * 1024 + col0 + bj * 128; const f32x4 a0 = acc[ai][bj][m][0], a1 = acc[ai][bj][m][1];
                    u32x4 w; w.x = pk2(a0[0], a0[1]); w.y = pk2(a0[2], a0[3]); w.z = pk2(a1[0], a1[1]); w.w = pk2(a1[2], a1[3]);
                    *(u32x4*)(PE + o) = w; } }
    }
};
struct EpiFinal {
    static constexpr bool PERM = true; static constexpr int MID_T = 0; static constexpr bool HAS_BIAS = false;
    const bf16_t* PE; const float* RSTD; const float* bias; float* out; const bf16_t* X1B;
    __device__ __forceinline__ void operator()(const f32x4 (&acc)[2][2][4][2], const Unit& u, int wr, int wc, int fr, int fq) const {
        const int row0 = u.pm * 256 + wr * 64 + fr, col0 = u.pn * 256 + wc * 32 + 8 * fq;
        f32x4 bv[2][2];
#pragma unroll
        for (int bj = 0; bj < 2; ++bj)
#pragma unroll
            for (int n = 0; n < 2; ++n) bv[bj][n] = *(const f32x4*)(bias + col0 + bj * 128 + 4 * n);
#pragma unroll
        for (int ai = 0; ai < 2; ++ai) {
            float rs[4]; u32x4 pw[4][2], xw[4][2];
#pragma unroll
            for (int m = 0; m < 4; ++m) { rs[m] = RSTD[row0 + ai * 128 + m * 16];
#pragma unroll
                for (int bj = 0; bj < 2; ++bj) { const size_t o = (size_t)(row0 + ai * 128 + m * 16) * 1024 + col0 + bj * 128;
                    pw[m][bj] = *(const u32x4*)(PE + o); xw[m][bj] = *(const u32x4*)(X1B + o); } }
#pragma unroll
            for (int m = 0; m < 4; ++m)
#pragma unroll
                for (int bj = 0; bj < 2; ++bj) { const size_t o = (size_t)(row0 + ai * 128 + m * 16) * 1024 + col0 + bj * 128;
                    const f32x4 a0 = acc[ai][bj][m][0] * rs[m] + bv[bj][0], a1 = acc[ai][bj][m][1] * rs[m] + bv[bj][1];
                    const u32x4 p = pw[m][bj], xq = xw[m][bj];
                    f32x4 r0, r1;
                    r0[0] = bflo(xq.x) + sigmoidf_(a0[0]) * bflo(p.x); r0[1] = bfhi(xq.x) + sigmoidf_(a0[1]) * bfhi(p.x); r0[2] = bflo(xq.y) + sigmoidf_(a0[2]) * bflo(p.y); r0[3] = bfhi(xq.y) + sigmoidf_(a0[3]) * bfhi(p.y);
                    r1[0] = bflo(xq.z) + sigmoidf_(a1[0]) * bflo(p.z); r1[1] = bfhi(xq.z) + sigmoidf_(a1[1]) * bfhi(p.z); r1[2] = bflo(xq.w) + sigmoidf_(a1[2]) * bflo(p.w); r1[3] = bfhi(xq.w) + sigmoidf_(a1[3]) * bfhi(p.w);
                    *(f32x4*)(out + o) = r0; *(f32x4*)(out + o + 4) = r1; }
            asm volatile("" ::: "memory"); }
    }
};

__device__ __forceinline__ void transpose_item(const float* W, int N, bf16_t* WT, int ldk, int k0, int n0, int drow0, const float* kscale, LAS float* scr, int lane) {
    float tv[32];
#pragma unroll
    for (int i = 0; i < 32; ++i) { const int kk = 2 * i + (lane >> 5); tv[i] = W[(size_t)(k0 + kk) * N + n0 + (lane & 31)]; }
#pragma unroll
    for (int i = 0; i < 32; ++i) { const int kk = 2 * i + (lane >> 5); float v = tv[i]; if (kscale) v *= kscale[k0 + kk]; scr[kk * 33 + (lane & 31)] = v; }
    LDS_WAIT();
    const int c = lane & 7;
#pragma unroll
    for (int j = 0; j < 4; ++j) { const int n = (lane >> 3) + 8 * j; const LAS float* s = scr + (8 * c) * 33 + n;
        u32x4 o; o.x = pk2(s[0 * 33], s[1 * 33]); o.y = pk2(s[2 * 33], s[3 * 33]); o.z = pk2(s[4 * 33], s[5 * 33]); o.w = pk2(s[6 * 33], s[7 * 33]);
        *(u32x4*)(WT + (size_t)(drow0 + n) * ldk + k0 + 8 * c) = o; }
    LDS_WAIT();
}
__device__ __forceinline__ int perm_col(int n) {
    if (n < 1280) return n;
    if (n < 2560) return n + 4864;
    if (n < 7168) return n - 1280;
    if (n < 7680) return n + 256;
    const int gi = n - 7680, which = gi >> 10, c = gi & 1023, gpos = (c >> 7) * 256 + which * 128 + (c & 127);
    return gpos < 256 ? 5888 + gpos : 7936 + (gpos - 256);
}

__device__ __forceinline__ void phase0(const Params& P, LAS unsigned char* L) {
    int tid = threadIdx.x; asm volatile("" : "+v"(tid));
    const int wid = tid >> 6, lane = tid & 63;
    const int gw = blockIdx.x * 8 + wid, NGW = gridDim.x * 8;
    const size_t gt = (size_t)blockIdx.x * 512 + tid, NGT = (size_t)gridDim.x * 512;
    unsigned char* ws = P.ws;
    { bf16_t* HN = (bf16_t*)(ws + OFF_HN);
      f32x4 gn[4];
#pragma unroll
      for (int j = 0; j < 4; ++j) gn[j] = *((const f32x4*)P.norm_mix + lane + 64 * j);
      for (int row = gw; row < MROWS; row += 4 * NGW) {
          f32x4 v[4][4];
#pragma unroll
          for (int r = 0; r < 4; ++r) { const int rr = row + r * NGW < MROWS ? row + r * NGW : row; const f32x4* xr = (const f32x4*)(P.x + (size_t)rr * DM) + lane;
#pragma unroll
              for (int j = 0; j < 4; ++j) v[r][j] = xr[64 * j]; }
#pragma unroll
          for (int r = 0; r < 4; ++r) { float s = 0.f;
#pragma unroll
              for (int j = 0; j < 4; ++j) s += (v[r][j][0] * v[r][j][0] + v[r][j][1] * v[r][j][1]) + (v[r][j][2] * v[r][j][2] + v[r][j][3] * v[r][j][3]);
              const float rstd = rsqrtf(wave_sum(s) * (1.0f / DM) + EPS);
              if (row + r * NGW < MROWS) { u32x2* o8 = (u32x2*)(HN + (size_t)(row + r * NGW) * DM) + lane;
#pragma unroll
                  for (int j = 0; j < 4; ++j) { u32x2 w; w.x = pk2(v[r][j][0] * rstd * gn[j][0], v[r][j][1] * rstd * gn[j][1]); w.y = pk2(v[r][j][2] * rstd * gn[j][2], v[r][j][3] * rstd * gn[j][3]); o8[64 * j] = w; } } }
      } }
    { bf16_t* PB = (bf16_t*)(ws + OFF_PB); const size_t NI = (size_t)MROWS * PLE / 8;
      for (size_t i = gt; i < NI; i += 4 * NGT) { f32x4 av[4], bw[4];
#pragma unroll
          for (int r = 0; r < 4; ++r) { const size_t ii = i + r * NGT < NI ? i + r * NGT : i; av[r] = *((const f32x4*)P.p + 2 * ii); bw[r] = *((const f32x4*)P.p + 2 * ii + 1); }
#pragma unroll
          for (int r = 0; r < 4; ++r) if (i + r * NGT < NI) { u32x4 w; w.x = pk2(av[r][0], av[r][1]); w.y = pk2(av[r][2], av[r][3]); w.z = pk2(bw[r][0], bw[r][1]); w.w = pk2(bw[r][2], bw[r][3]); *((u32x4*)PB + i + r * NGT) = w; } } }
    { LAS float* scr = (LAS float*)(L + wid * 8448);
      constexpr int I0 = 16 * 304, I1 = 20 * 32, I2 = 8 * 32, I3 = 16 * 32, I4 = 16 * 32, I5 = 4 * 32, I6 = 80, I7 = 80;
      constexpr int NIT = I0 + I1 + I2 + I3 + I4 + I5 + I6 + I7;
      for (int it = gw; it < NIT; it += NGW) {
          int r = it;
          if (r < I0) { const int kb = r / 304, nb = r % 304; transpose_item(P.w_in, NIN, (bf16_t*)(ws + OFF_WIN), DM, 64 * kb, 32 * nb, perm_col(32 * nb), nullptr, scr, lane); continue; } r -= I0;
          if (r < I1) { const int kb = r / 32, nb = r % 32; transpose_item(P.w_o_rnn, DM, (bf16_t*)(ws + OFF_WR), 1792, 64 * kb, 32 * nb, 32 * nb, nullptr, scr, lane); continue; } r -= I1;
          if (r < I2) { const int kb = r / 32, nb = r % 32; transpose_item(P.w_o_att, DM, (bf16_t*)(ws + OFF_WR) + DRNN, 1792, 64 * kb, 32 * nb, 32 * nb, nullptr, scr, lane); continue; } r -= I2;
          if (r < I3) { const int kb = r / 32, nb = r % 32; transpose_item(P.w_out, DM, (bf16_t*)(ws + OFF_WOUT), DM, 64 * kb, 32 * nb, 32 * nb, nullptr, scr, lane); continue; } r -= I3;
          if (r < I4) { const int kb = r / 32, nb = r % 32; transpose_item(P.w_ple_gate, DM, (bf16_t*)(ws + OFF_WPG), DM, 64 * kb, 32 * nb, 32 * nb, P.norm_ple, scr, lane); continue; } r -= I4;
          if (r < I5) { const int kb = r / 32, nb = r % 32; transpose_item(P.w_ple, DM, (bf16_t*)(ws + OFF_WPE), PLE, 64 * kb, 32 * nb, 32 * nb, nullptr, scr, lane); continue; } r -= I5;
          if (r < I6) { const int mt = r / 8, q = r % 8, kb = q / 4, nb = q % 4; transpose_item(P.w_rg_a + (size_t)mt * 16384, 128, (bf16_t*)(ws + OFF_WGA) + (size_t)mt * 16384, 128, 64 * kb, 32 * nb, 32 * nb, nullptr, scr, lane); continue; } r -= I6;
          { const int mt = r / 8, q = r % 8, kb = q / 4, nb = q % 4; transpose_item(P.w_rg_x + (size_t)mt * 16384, 128, (bf16_t*)(ws + OFF_WGX) + (size_t)mt * 16384, 128, 64 * kb, 32 * nb, 32 * nb, nullptr, scr, lane); }
      } }
    { float* BIN = (float*)(ws + OFF_BIN);
      for (size_t i = gt; i < (size_t)NIN; i += NGT) BIN[perm_col((int)i)] = P.b_in[i];
      float* RC = (float*)(ws + OFF_ROPE); float* RS = RC + SEQ * 64;
      for (size_t i = gt; i < (size_t)SEQ * 64; i += NGT) { const int pos = (int)(i >> 6), j = (int)(i & 63);
          const float inv_freq = (float)exp2(-(double)j * (13.287712379549449 / 64.0));
          const float angf = (float)pos * inv_freq; const double ang = (double)angf; const double k = rint(ang * 0.15915494309189535);
          const float rr = (float)(ang - k * 6.283185307179586);
          RC[i] = __cosf(rr); RS[i] = __sinf(rr); } }
}

typedef float f32x2 __attribute__((ext_vector_type(2)));
__device__ __forceinline__ void norm_rope(u32x4 (&raw)[4], const LAS float* gain_fq, const f32x2 (&cs)[2][4], const f32x2 (&sn)[2][4], float scale) {
    f32x2 v[4][4]; f32x2 ss2 = (f32x2){0.f, 0.f};
#pragma unroll
    for (int kk = 0; kk < 4; ++kk)
#pragma unroll
        for (int i = 0; i < 4; ++i) { const unsigned w = raw[kk][i]; v[kk][i] = (f32x2){bflo(w), bfhi(w)}; ss2 = v[kk][i] * v[kk][i] + ss2; }
    float ss = ss2.x + ss2.y;
    ss += __shfl_xor(ss, 16); ss += __shfl_xor(ss, 32);
    const float rstd = rsqrtf(ss * (1.0f / 128.0f) + EPS) * scale;
#pragma unroll
    for (int kk = 0; kk < 4; ++kk) { const f32x4 g0 = *(const LAS f32x4*)(gain_fq + kk * 32), g1 = *(const LAS f32x4*)(gain_fq + kk * 32 + 4);
        v[kk][0] *= (f32x2){g0[0], g0[1]}; v[kk][1] *= (f32x2){g0[2], g0[3]}; v[kk][2] *= (f32x2){g1[0], g1[1]}; v[kk][3] *= (f32x2){g1[2], g1[3]}; }
#pragma unroll
    for (int kk = 0; kk < 2; ++kk)
#pragma unroll
        for (int i = 0; i < 4; ++i) { const f32x2 cc = cs[kk][i] * rstd, sc = sn[kk][i] * rstd; const f32x2 t1 = v[kk][i], t2 = v[kk + 2][i];
            v[kk][i] = t1 * cc - t2 * sc; v[kk + 2][i] = t2 * cc + t1 * sc; }
#pragma unroll
    for (int kk = 0; kk < 4; ++kk)
#pragma unroll
        for (int i = 0; i < 4; ++i) raw[kk][i] = pk2(v[kk][i].x, v[kk][i].y);
}

__device__ __forceinline__ void attn_seq(const Params& P, LAS unsigned char* L, int u, unsigned* ctr, LAS int* bc) {
    int nxt = 0;
    int tid = threadIdx.x; asm volatile("" : "+v"(tid));
    const int wid = tid >> 6, lane = tid & 63, fr = lane & 15, fq = lane >> 4;
    int g, b, h, c, nblk;
    if (u < 64) { g = 0; b = u >> 2; h = u & 3; c = 0; nblk = 16; }
    else if (u < 320) { const int r = u - 64; g = 1; b = r >> 4; h = (r >> 2) & 3; c = r & 3; nblk = 4; }
    else { const int r = u - 320; g = 2; b = r >> 6; h = (r >> 4) & 3; c = r & 15; nblk = 1; }
    const int dil = 1 << (2 * g);
    const bf16_t* QKV = (const bf16_t*)(P.ws + OFF_R);
    const int qcol = g * 1536 + h * 128;
    const size_t brow = (size_t)b * SEQ;
    const LAS float* gl = (const LAS float*)(L + GAIN_OFF) + g * 256;
    const LAS float* kgain = gl + fq * 8; const LAS float* qgain = gl + 128 + fq * 8;
    f32x2 frev[2][4];
#pragma unroll
    for (int kk = 0; kk < 2; ++kk)
#pragma unroll
        for (int i = 0; i < 4; ++i) { const float j0 = (float)(kk * 32 + fq * 8 + 2 * i);
            frev[kk][i] = (f32x2){__builtin_amdgcn_exp2f(-j0 * (13.287712379549449f / 64.0f)) * 0.15915494309189535f, __builtin_amdgcn_exp2f(-(j0 + 1.0f) * (13.287712379549449f / 64.0f)) * 0.15915494309189535f}; }
    const int dg = (lane >> 4) + 4 * (wid & 3), kg = (lane & 15) + 16 * (wid >> 2);
    u32x4 qraw[4], kraw[4], vraw[4];
    { const bf16_t* qp = QKV + (brow + (size_t)(16 * wid + fr) * dil + c) * QKVW + qcol + fq * 8;
#pragma unroll
      for (int kk = 0; kk < 4; ++kk) { qraw[kk] = *(const u32x4*)(qp + kk * 32); kraw[kk] = *(const u32x4*)(qp + 512 + kk * 32); }
#pragma unroll
      for (int i = 0; i < 4; ++i) vraw[i] = *(const u32x4*)(QKV + (brow + (size_t)(4 * kg + i) * dil + c) * QKVW + qcol + 1024 + dg * 8); }
    for (int n = 0; n < nblk; ++n) {
        const int slot = n & 1, kx = slot ? 0 : 8;
        const int sq = (128 * n + 16 * wid + fr) * dil + c;
        f32x2 cs[2][4], sn[2][4];
#pragma unroll
        for (int kk = 0; kk < 2; ++kk)
#pragma unroll
            for (int i = 0; i < 4; ++i) { const f32x2 rv = frev[kk][i] * (float)sq; const float r0 = __builtin_amdgcn_fractf(rv.x), r1 = __builtin_amdgcn_fractf(rv.y);
                cs[kk][i] = (f32x2){__builtin_amdgcn_cosf(r0), __builtin_amdgcn_cosf(r1)}; sn[kk][i] = (f32x2){__builtin_amdgcn_sinf(r0), __builtin_amdgcn_sinf(r1)}; }
        norm_rope(kraw, kgain, cs, sn, 1.0f);
#pragma unroll
        for (int kk = 0; kk < 4; ++kk) *(LAS u32x4*)(L + (slot * 128 + 16 * wid + fr) * KS_STRIDE + (kk * 32 + fq * 8) * 2) = kraw[kk];
#pragma unroll
        for (int d = 0; d < 8; ++d) { u32x2 o;
            o.x = __builtin_amdgcn_perm(vraw[1][d >> 1], vraw[0][d >> 1], (d & 1) ? 0x07060302u : 0x05040100u);
            o.y = __builtin_amdgcn_perm(vraw[3][d >> 1], vraw[2][d >> 1], (d & 1) ? 0x07060302u : 0x05040100u);
            *(LAS u32x2*)(L + VT_OFF + (8 * dg + d) * VT_STRIDE + (slot * 128 + 4 * kg) * 2) = o;
            if (n == 0) *(LAS u32x2*)(L + VT_OFF + (8 * dg + d) * VT_STRIDE + ((slot ^ 1) * 128 + 4 * kg) * 2) = (u32x2){0u, 0u}; }
        norm_rope(qraw, qgain, cs, sn, 0.08838834764831845f * 1.4426950408889634f);
        bf16x8 qf[4];
#pragma unroll
        for (int kk = 0; kk < 4; ++kk) qf[kk] = __builtin_bit_cast(bf16x8, qraw[kk]);
        __syncthreads();
        if (n + 1 == nblk && threadIdx.x == 0) nxt = (int)atomicAdd(ctr, 1u);
        if (n + 1 < nblk) { const bf16_t* qp = QKV + (brow + (size_t)(128 * (n + 1) + 16 * wid + fr) * dil + c) * QKVW + qcol + fq * 8;
#pragma unroll
            for (int kk = 0; kk < 4; ++kk) { qraw[kk] = *(const u32x4*)(qp + kk * 32); kraw[kk] = *(const u32x4*)(qp + 512 + kk * 32); }
#pragma unroll
            for (int i = 0; i < 4; ++i) vraw[i] = *(const u32x4*)(QKV + (brow + (size_t)(128 * (n + 1) + 4 * kg + i) * dil + c) * QKVW + qcol + 1024 + dg * 8); }
        f32x4 sacc[10];
#pragma unroll
        for (int p = 0; p < 9; ++p) { sacc[p] = (f32x4){0.f, 0.f, 0.f, 0.f}; const int kt = wid + p;
            if (n > 0 || kt >= 8) { const int ktp = kt ^ kx;
#pragma unroll
                for (int kk = 0; kk < 4; ++kk) { const bf16x8 a = *(const LAS bf16x8*)(L + (16 * ktp + fr) * KS_STRIDE + (kk * 32 + fq * 8) * 2);
                    sacc[p] = __builtin_amdgcn_mfma_f32_16x16x32_bf16(a, qf[kk], sacc[p], 0, 0, 0); } } }
        float mx = -INFINITY;
#pragma unroll
        for (int p = 0; p < 9; ++p) { const bool tile_ok = (n > 0) || (wid + p >= 8);
#pragma unroll
            for (int jj = 0; jj < 4; ++jj) { const int e = 4 * fq + jj - fr;
                const bool valid = tile_ok && (p == 0 ? e >= 0 : (p == 8 ? e <= 0 : true));
                sacc[p][jj] = valid ? sacc[p][jj] : -INFINITY; mx = fmaxf(mx, sacc[p][jj]); } }
        mx = fmaxf(mx, __shfl_xor(mx, 16)); mx = fmaxf(mx, __shfl_xor(mx, 32));
        float den = 0.f;
#pragma unroll
        for (int p = 0; p < 9; ++p)
#pragma unroll
            for (int jj = 0; jj < 4; ++jj) { const float e = __builtin_amdgcn_exp2f(sacc[p][jj] - mx); sacc[p][jj] = e; den += e; }
        sacc[9] = (f32x4){0.f, 0.f, 0.f, 0.f};
        den += __shfl_xor(den, 16); den += __shfl_xor(den, 32);
        f32x4 oacc[8];
#pragma unroll
        for (int dt = 0; dt < 8; ++dt) oacc[dt] = (f32x4){0.f, 0.f, 0.f, 0.f};
#pragma unroll
        for (int pp = 0; pp < 5; ++pp) { const int kt0 = wid + 2 * pp, kt1 = (kt0 + 1 < 16) ? kt0 + 1 : 15;
            if (n > 0 || kt0 + 1 >= 8) { const int kp0 = kt0 ^ kx, kp1 = kt1 ^ kx;
                u32x4 pw; pw.x = pk2(sacc[2 * pp][0], sacc[2 * pp][1]); pw.y = pk2(sacc[2 * pp][2], sacc[2 * pp][3]); pw.z = pk2(sacc[2 * pp + 1][0], sacc[2 * pp + 1][1]); pw.w = pk2(sacc[2 * pp + 1][2], sacc[2 * pp + 1][3]);
                const bf16x8 pb = __builtin_bit_cast(bf16x8, pw);
#pragma unroll
                for (int dt = 0; dt < 8; ++dt) { const LAS unsigned char* vrow = L + VT_OFF + (16 * dt + fr) * VT_STRIDE + (4 * fq) * 2;
                    const u32x2 lo = *(const LAS u32x2*)(vrow + kp0 * 32), hi = *(const LAS u32x2*)(vrow + kp1 * 32);
                    u32x4 aw; aw.x = lo.x; aw.y = lo.y; aw.z = hi.x; aw.w = hi.y;
                    oacc[dt] = __builtin_amdgcn_mfma_f32_16x16x32_bf16(__builtin_bit_cast(bf16x8, aw), pb, oacc[dt], 0, 0, 0); } } }
        if (n + 1 == nblk && threadIdx.x == 0) *bc = nxt;
        { const float inv = 1.0f / den; const size_t row = brow + sq;
          bf16_t* OG = (bf16_t*)P.out + ((size_t)g * MROWS + row) * ATTW + h * 128 + 4 * fq;
#pragma unroll
          for (int dt = 0; dt < 8; ++dt) { u32x2 w; w.x = pk2(oacc[dt][0] * inv, oacc[dt][1] * inv); w.y = pk2(oacc[dt][2] * inv, oacc[dt][3] * inv); *(u32x2*)(OG + 16 * dt) = w; }
          if (fq == 0) ((float*)(P.ws + OFF_LSE))[((size_t)g * MROWS + row) * 4 + h] = (mx + __log2f(den)) * 0.6931471805599453f; }
        asm volatile("s_waitcnt lgkmcnt(0)" ::: "memory"); __builtin_amdgcn_s_barrier(); asm volatile("" ::: "memory");
    }
}

constexpr int LXC = 128 * XC_STRIDE;
constexpr int HS_OFF = 2 * LXC, HALO_OFF = 4 * LXC;
__device__ __forceinline__ void lru_seq(const Params& P, LAS unsigned char* L, int it, unsigned* ctr, LAS int* qnext) {
    int nxt = 0;
    int tid = threadIdx.x; asm volatile("" : "+v"(tid));
    const int wid = tid >> 6, lane = tid & 63, fr = lane & 15, fq = lane >> 4;
    const int b = it / 10, n = it % 10;
    bf16_t* XR = (bf16_t*)(P.ws + OFF_XR);
    const int cg8 = tid & 15, tg = tid >> 4, ch0 = 128 * n + 8 * cg8;
    f32x2 wk[4][4], bc[4];
#pragma unroll
    for (int k = 0; k < 4; ++k) { const f32x4 a = *(const f32x4*)(P.conv_w + k * DRNN + ch0), bq = *(const f32x4*)(P.conv_w + k * DRNN + ch0 + 4);
        wk[k][0] = (f32x2){a[0], a[1]}; wk[k][1] = (f32x2){a[2], a[3]}; wk[k][2] = (f32x2){bq[0], bq[1]}; wk[k][3] = (f32x2){bq[2], bq[3]}; }
    { const f32x4 a = *(const f32x4*)(P.conv_b + ch0), bq = *(const f32x4*)(P.conv_b + ch0 + 4);
      bc[0] = (f32x2){a[0], a[1]}; bc[1] = (f32x2){a[2], a[3]}; bc[2] = (f32x2){bq[0], bq[1]}; bc[3] = (f32x2){bq[2], bq[3]}; }
    const int ch = 128 * n + 16 * wid + fr;
    bf16x8 bfa[4], bfx[4];
    { const bf16_t* WA = (const bf16_t*)(P.ws + OFF_WGA) + (size_t)n * 16384 + (16 * wid + fr) * 128 + fq * 8;
      const bf16_t* WX = (const bf16_t*)(P.ws + OFF_WGX) + (size_t)n * 16384 + (16 * wid + fr) * 128 + fq * 8;
#pragma unroll
      for (int kk = 0; kk < 4; ++kk) { bfa[kk] = __builtin_bit_cast(bf16x8, *(const u32x4*)(WA + kk * 32)); bfx[kk] = __builtin_bit_cast(bf16x8, *(const u32x4*)(WX + kk * 32)); } }
    const float LOG2E = 1.4426950408889634f;
    const float ba2 = -P.b_rg_a[ch] * LOG2E, bx2 = -P.b_rg_x[ch] * LOG2E, cs = -8.0f * LOG2E * log1pf(__expf(-P.lam[ch]));
    float hc = 0.f;
    u32x4 xw[7];
    const bf16_t* xrow = XR + ((size_t)b * SEQ + 4 * tg - 3) * DRNN + ch0;
#pragma unroll
    for (int ri = 0; ri < 7; ++ri) xw[ri] = (tg == 0 && ri < 3) ? (u32x4){0u, 0u, 0u, 0u} : *(const u32x4*)(xrow + (size_t)ri * DRNN);
    auto stepA = [&](int ca) {
        if (tg == 0 && ca > 0) {
#pragma unroll
            for (int ri = 0; ri < 3; ++ri) xw[ri] = *(const LAS u32x4*)(L + HALO_OFF + ((ca & 1) ^ 1) * 768 + ri * 256 + cg8 * 16); }
        if (tg == 31) {
#pragma unroll
            for (int ri = 4; ri < 7; ++ri) *(LAS u32x4*)(L + HALO_OFF + (ca & 1) * 768 + (ri - 4) * 256 + cg8 * 16) = xw[ri]; }
        f32x2 xin[7][4];
#pragma unroll
        for (int ri = 0; ri < 7; ++ri)
#pragma unroll
            for (int i = 0; i < 4; ++i) xin[ri][i] = (f32x2){bflo(xw[ri][i]), bfhi(xw[ri][i])};
#pragma unroll
        for (int o = 0; o < 4; ++o) { u32x4 w;
#pragma unroll
            for (int i = 0; i < 4; ++i) { const f32x2 y = wk[3][i] * xin[o + 3][i] + (wk[2][i] * xin[o + 2][i] + (wk[1][i] * xin[o + 1][i] + (wk[0][i] * xin[o][i] + bc[i]))); w[i] = pk2(y.x, y.y); }
            *(LAS u32x4*)(L + (ca & 1) * LXC + (4 * tg + o) * XC_STRIDE + cg8 * 16) = w; }
    };
    stepA(0);
    __syncthreads();
    for (int ck = 0; ck < 16; ++ck) {
        const int t0 = ck * 128;
        LAS unsigned char* Xc = L + (ck & 1) * LXC; LAS unsigned char* Hs = L + HS_OFF + (ck & 1) * LXC;
        if (ck == 15 && threadIdx.x == 0) nxt = (int)atomicAdd(ctr, 1u);
        if (ck < 15) {
#pragma unroll
            for (int ri = 0; ri < 7; ++ri) if (!(tg == 0 && ri < 3)) xw[ri] = *(const u32x4*)(xrow + (size_t)(t0 + 128 + ri) * DRNN); }
#pragma unroll
        for (int m = 0; m < 8; ++m) {
            f32x4 aa = (f32x4){0.f, 0.f, 0.f, 0.f}, ax = (f32x4){0.f, 0.f, 0.f, 0.f};
#pragma unroll
            for (int kk = 0; kk < 4; ++kk) { const bf16x8 a = *(const LAS bf16x8*)(Xc + (16 * m + fr) * XC_STRIDE + (kk * 32 + fq * 8) * 2);
                aa = __builtin_amdgcn_mfma_f32_16x16x32_bf16(a, bfa[kk], aa, 0, 0, 0); ax = __builtin_amdgcn_mfma_f32_16x16x32_bf16(a, bfx[kk], ax, 0, 0, 0); }
            float av[4], uv[4];
#pragma unroll
            for (int jj = 0; jj < 4; ++jj) { const int tl = 16 * m + 4 * fq + jj;
                const float rg = __builtin_amdgcn_rcpf(1.0f + __builtin_amdgcn_exp2f(fmaf(aa[jj], -LOG2E, ba2)));
                const float ig = __builtin_amdgcn_rcpf(1.0f + __builtin_amdgcn_exp2f(fmaf(ax[jj], -LOG2E, bx2)));
                const float a = __builtin_amdgcn_exp2f(cs * rg);
                float mult = __builtin_amdgcn_sqrtf(fmaf(-a, a, 1.0f));
                if (m == 0 && jj == 0) mult = (ck == 0 && fq == 0) ? 1.0f : mult;
                const float xcv = bf2f(*(const LAS bf16_t*)(Xc + tl * XC_STRIDE + (16 * wid + fr) * 2));
                av[jj] = a; uv[jj] = mult * ig * xcv; }
            float AL = av[0], HL = uv[0];
#pragma unroll
            for (int jj = 1; jj < 4; ++jj) { HL = fmaf(av[jj], HL, uv[jj]); AL *= av[jj]; }
            const float A0 = __shfl(AL, fr), H0 = __shfl(HL, fr), A1 = __shfl(AL, fr + 16), H1 = __shfl(HL, fr + 16), A2 = __shfl(AL, fr + 32), H2 = __shfl(HL, fr + 32), A3 = __shfl(AL, fr + 48), H3 = __shfl(HL, fr + 48);
            const float h0 = hc, h1 = fmaf(A0, h0, H0), h2 = fmaf(A1, h1, H1), h3 = fmaf(A2, h2, H2), he = fmaf(A3, h3, H3);
            float hh = fq == 0 ? h0 : (fq == 1 ? h1 : (fq == 2 ? h2 : h3));
#pragma unroll
            for (int jj = 0; jj < 4; ++jj) { hh = fmaf(av[jj], hh, uv[jj]);
                *(LAS bf16_t*)(Hs + (16 * m + 4 * fq + jj) * XC_STRIDE + (16 * wid + fr) * 2) = (bf16_t)(pk2(hh, 0.f) & 0xffffu); }
            hc = he;
        }
        if (ck < 15) stepA(ck + 1);
        if (ck == 15 && threadIdx.x == 0) *qnext = nxt;
        __syncthreads();
#pragma unroll
        for (int o = 0; o < 4; ++o) *(u32x4*)(XR + ((size_t)b * SEQ + t0 + 4 * tg + o) * DRNN + ch0) = *(const LAS u32x4*)(Hs + (4 * tg + o) * XC_STRIDE + cg8 * 16);
    }
    __syncthreads();
}

#define XB_TMO      128
#define XB_XCNT(j)  (256  + 64 * (j))
#define XB_XSUB(j)  (1280 + 64 * (j))
#define XB_XGEN(j)  (2304 + 64 * (j))
#define XB_TOP      3328
#define XB_TOPGEN   3392
#define XCD_BAR_WORDS 3456
#define XB_SPIN_CAP (1u << 18)
__device__ __forceinline__ unsigned xb_ld(unsigned* p)              { return __hip_atomic_load(p, __ATOMIC_RELAXED, __HIP_MEMORY_SCOPE_AGENT); }
__device__ __forceinline__ unsigned xb_add(unsigned* p, unsigned v) { return __hip_atomic_fetch_add(p, v, __ATOMIC_RELAXED, __HIP_MEMORY_SCOPE_AGENT); }
__device__ __forceinline__ unsigned xb_xcc_id() { return (unsigned)__builtin_amdgcn_s_getreg((3 << 11) | 20) & 0xFu; }
#define XB_SPIN(cond, bar) do { unsigned _sp = 0; while (cond) { __builtin_amdgcn_s_sleep(1); \
    if ((++_sp & 255u) == 0u) { if (xb_ld(&(bar)[XB_TMO])) break; if (_sp > XB_SPIN_CAP) { atomicAdd(&(bar)[XB_TMO], 1u); break; } } } } while (0)
struct XcdBarrier { unsigned* bar; unsigned x; volatile LAS unsigned* st; };
__device__ __forceinline__ XcdBarrier xcd_barrier_post(unsigned* bar, volatile LAS unsigned* st) {
    XcdBarrier b; b.bar = bar; b.x = xb_xcc_id(); b.st = st;
    if (threadIdx.x == 0) (void)xb_add(&bar[XB_XCNT(b.x)], 1u);
    return b;
}
__device__ __forceinline__ void xcd_barrier_complete(unsigned* bar, unsigned x, unsigned& nloc, unsigned& nx) {
    const unsigned G = gridDim.x * gridDim.y * gridDim.z;
    unsigned sum, cnt, mine, sp = 0u;
    for (;;) {
        sum = 0u; cnt = 0u; mine = 0u;
#pragma unroll
        for (unsigned j = 0; j < 16; ++j) { const unsigned c = xb_ld(&bar[XB_XCNT(j)]); sum += c; cnt += (c > 0u) ? 1u : 0u; mine = (j == x) ? c : mine; }
        if (sum == G) break;
        __builtin_amdgcn_s_sleep(1);
        if ((++sp & 255u) == 0u) { if (xb_ld(&bar[XB_TMO])) break; if (sp > XB_SPIN_CAP) { atomicAdd(&bar[XB_TMO], 1u); break; } }
    }
    nloc = mine > 0u ? mine : 1u; nx = cnt > 0u ? cnt : 1u;
}
__device__ __forceinline__ void xcd_barrier(const XcdBarrier& b) {
    asm volatile("s_waitcnt vmcnt(0)" ::: "memory");
    __syncthreads();
    if (threadIdx.x == 0) {
        unsigned* bar = b.bar;
        __builtin_amdgcn_s_waitcnt(0);
        unsigned nloc = b.st[0], nx = b.st[1];
        if (nloc == 0u) { xcd_barrier_complete(bar, b.x, nloc, nx); b.st[0] = nloc; b.st[1] = nx; }
        const unsigned old = xb_add(&bar[XB_XSUB(b.x)], 1u);
        const unsigned gen = old / nloc;
        if (old + 1u == (gen + 1u) * nloc) {
            __builtin_amdgcn_fence(__ATOMIC_RELEASE, "agent");
            asm volatile("s_waitcnt vmcnt(0)" ::: "memory");
            const unsigned og = xb_add(&bar[XB_TOP], 1u);
            const unsigned tg = og / nx;
            if (og + 1u == (tg + 1u) * nx) xb_add(&bar[XB_TOPGEN], 1u);
            else XB_SPIN(xb_ld(&bar[XB_TOPGEN]) == tg, bar);
            __builtin_amdgcn_fence(__ATOMIC_ACQUIRE, "agent");
            xb_add(&bar[XB_XGEN(b.x)], 1u);
            asm volatile("s_waitcnt vmcnt(0)" ::: "memory");
        } else {
            XB_SPIN(xb_ld(&bar[XB_XGEN(b.x)]) == gen, bar);
            __builtin_amdgcn_fence(__ATOMIC_ACQUIRE, "agent");
            asm volatile("s_waitcnt vmcnt(0)" ::: "memory");
        }
    }
    __syncthreads();
}

#ifndef REPEAT_MASK
#define REPEAT_MASK 0
#endif
#define NREP(bit) (((REPEAT_MASK >> (bit)) & 1) ? 2 : 1)
__global__ void __launch_bounds__(512, 2) fwd_megakernel(Params P) {
    extern __shared__ __attribute__((aligned(16))) unsigned char shm[];
    LAS unsigned char* L = (LAS unsigned char*)shm;
    cg::grid_group grid = cg::this_grid();
    unsigned char* ws = P.ws;
    const int G = (int)gridDim.x, c = (int)blockIdx.x;
    pg8::StaticOrder S;
    volatile LAS unsigned* xst = (volatile LAS unsigned*)(L + LDS_BYTES - 8);
    if (threadIdx.x == 0) { xst[0] = 0u; xst[1] = 0u; }
    __syncthreads();
    if (ws == nullptr) grid.sync();
    const XcdBarrier xb = xcd_barrier_post((unsigned*)(ws + OFF_BAR), xst);
    for (int rep = 0; rep < NREP(0); ++rep) phase0(P, L);
    xcd_barrier(xb);
    for (int rep = 0; rep < NREP(1); ++rep)
    { pg8::Gemm g{(const bf16_t*)(ws + OFF_HN), (const bf16_t*)(ws + OFF_WIN), MROWS, NA, DM}; S.init(MROWS, NA, G, c);
      EpiProj<0> E{(const float*)(ws + OFF_BIN), ws, nullptr};
      pg8::gemm_phase(L, g, S, E); }
    xcd_barrier(xb);
    {
        unsigned* ctr = (unsigned*)(ws + OFF_CTR);
        LAS int* bc = (LAS int*)(L + LDS_BYTES - 16);
        { LAS float* gl = (LAS float*)(L + GAIN_OFF);
          for (int i = threadIdx.x; i < 768; i += 512) { const int gq = i >> 8, j = i & 255; gl[i] = j < 128 ? P.k_norm[gq * 128 + j] : P.q_norm[gq * 128 + j - 128]; } }
        if (threadIdx.x == 0) *bc = (int)atomicAdd(ctr, 1u);
        __syncthreads();
        for (;;) {
            const int it = *bc;
            if (it >= 160 + 1344) break;
            if (it < 64) attn_seq(P, L, it, ctr, bc); else if (it < 224) lru_seq(P, L, it - 64, ctr, bc); else attn_seq(P, L, it - 160, ctr, bc);
        }
        __syncthreads();
    }
    xcd_barrier(xb);
    for (int rep = 0; rep < NREP(3); ++rep)
    { pg8::Gemm g{(const bf16_t*)(ws + OFF_HN), (const bf16_t*)(ws + OFF_WIN) + (size_t)NA * DM, MROWS, NB, DM}; S.init(MROWS, NB, G, c);
      EpiProj<1> E{(const float*)(ws + OFF_BIN) + NA, ws, (const void*)P.out};
      pg8::gemm_phase(L, g, S, E); }
    xcd_barrier(xb);
    for (int rep = 0; rep < NREP(4); ++rep)
    { pg8::Gemm g{(const bf16_t*)(ws + OFF_ZR), (const bf16_t*)(ws + OFF_WR), MROWS, DM, 1792}; S.init(MROWS, DM, G, c);
      EpiMergeFused E{(const bf16_t*)(ws + OFF_G), (bf16_t*)(ws + OFF_HN), (const bf16_t*)(ws + OFF_GX)};
      pg8::gemm_phase(L, g, S, E); }
    xcd_barrier(xb);
    for (int rep = 0; rep < NREP(5); ++rep)
    { pg8::Gemm g{(const bf16_t*)(ws + OFF_HN), (const bf16_t*)(ws + OFF_WOUT), MROWS, DM, DM}; S.init(MROWS, DM, G, c);
      EpiX1 E{P.x, P.out, (bf16_t*)(ws + OFF_XR), (float*)(ws + OFF_SSQ)};
      pg8::gemm_phase(L, g, S, E); }
    xcd_barrier(xb);
    for (int rep = 0; rep < NREP(6); ++rep) {
    { pg8::Gemm g{(const bf16_t*)(ws + OFF_PB), (const bf16_t*)(ws + OFF_WPE), MROWS, DM, PLE}; S.init(MROWS, DM, G, c);
      EpiPe E{(bf16_t*)(ws + OFF_G), (const float*)(ws + OFF_SSQ), (float*)(ws + OFF_TOT)};
      pg8::gemm_phase(L, g, S, E); }
    { pg8::Gemm g{(const bf16_t*)(ws + OFF_XR), (const bf16_t*)(ws + OFF_WPG), MROWS, DM, DM}; S.init(MROWS, DM, G, c);
      EpiFinal E{(const bf16_t*)(ws + OFF_G), (const float*)(ws + OFF_TOT), P.b_ple_gate, P.out, (const bf16_t*)(ws + OFF_XR)};
      pg8::gemm_phase(L, g, S, E); } }
}

extern "C" void kernel_launch(void* const* d_in, const int* in_sizes, int n_in, void* d_out, int out_size, void* d_ws, size_t ws_size, hipStream_t stream) {
    static int grid_blocks = 0;
    if (grid_blocks == 0) {
        if (n_in != 21 || in_sizes[0] != MROWS * DM || out_size != MROWS * DM || ws_size < WS_END) { fprintf(stderr, "kernel_launch: unexpected shapes / workspace (n_in %d, ws %zu, need %zu)\n", n_in, ws_size, (size_t)WS_END); grid_blocks = -1; return; }
        int dev = 0, cus = 0, per_cu = 0;
        (void)hipGetDevice(&dev);
        (void)hipDeviceGetAttribute(&cus, hipDeviceAttributeMultiprocessorCount, dev);
        if (hipFuncSetAttribute((const void*)fwd_megakernel, hipFuncAttributeMaxDynamicSharedMemorySize, LDS_BYTES) != hipSuccess) { fprintf(stderr, "kernel_launch: hipFuncSetAttribute failed\n"); grid_blocks = -1; return; }
        if (hipOccupancyMaxActiveBlocksPerMultiprocessor(&per_cu, (const void*)fwd_megakernel, 512, LDS_BYTES) != hipSuccess || per_cu < 1) { fprintf(stderr, "kernel_launch: occupancy query failed (%d)\n", per_cu); per_cu = 1; (void)hipGetLastError(); }
        grid_blocks = cus * 1;
    }
    if (grid_blocks < 0) return;
    Params P{};
    P.x = (const float*)d_in[0]; P.p = (const float*)d_in[1]; P.norm_mix = (const float*)d_in[2]; P.w_in = (const float*)d_in[3]; P.b_in = (const float*)d_in[4];
    P.conv_w = (const float*)d_in[5]; P.conv_b = (const float*)d_in[6]; P.w_rg_a = (const float*)d_in[7]; P.b_rg_a = (const float*)d_in[8]; P.w_rg_x = (const float*)d_in[9]; P.b_rg_x = (const float*)d_in[10];
    P.lam = (const float*)d_in[11]; P.q_norm = (const float*)d_in[12]; P.k_norm = (const float*)d_in[13]; P.w_o_rnn = (const float*)d_in[14]; P.w_o_att = (const float*)d_in[15]; P.w_out = (const float*)d_in[16];
    P.norm_ple = (const float*)d_in[17]; P.w_ple_gate = (const float*)d_in[18]; P.b_ple_gate = (const float*)d_in[19]; P.w_ple = (const float*)d_in[20];
    P.out = (float*)d_out; P.ws = (unsigned char*)d_ws;
    if (hipMemsetAsync((char*)d_ws + OFF_CTR, 0, OFF_HN - OFF_CTR, stream) != hipSuccess) { fprintf(stderr, "kernel_launch: hipMemsetAsync of the barrier / queue words failed\n"); return; }
    void* args[] = {&P};
    hipError_t e = hipLaunchCooperativeKernel((const void*)fwd_megakernel, dim3(grid_blocks), dim3(512), args, LDS_BYTES, stream);
    if (e != hipSuccess) fprintf(stderr, "cooperative launch failed: %s (grid %d)\n", hipGetErrorString(e), grid_blocks);
}
```

```cpp
#include <hip/hip_runtime.h>
#include <hip/hip_cooperative_groups.h>
#include <cstdio>
namespace cg = cooperative_groups;

#define LAS __attribute__((address_space(3)))
typedef unsigned short bf16_t;
typedef short bf16x8 __attribute__((ext_vector_type(8)));
typedef float f32x4 __attribute__((ext_vector_type(4)));
typedef unsigned u32x4 __attribute__((ext_vector_type(4)));
typedef unsigned u32x2 __attribute__((ext_vector_type(2)));

constexpr int MROWS = 32768, SEQ = 2048, DM = 1024, DRNN = 1280, NIN = 9728, PLE = 256, QKVW = 4608, ATTW = 512;
constexpr int NA = 6144;
constexpr int NB = 3584;
constexpr float EPS = 1e-6f;

constexpr size_t al256(size_t x) { return (x + 255) & ~(size_t)255; }
constexpr size_t OFF_WIN = 0;
constexpr size_t OFF_WR = al256(OFF_WIN + (size_t)NIN * DM * 2);
constexpr size_t OFF_WA = al256(OFF_WR + (size_t)DM * DRNN * 2);
constexpr size_t OFF_WOUT = al256(OFF_WA + (size_t)DM * ATTW * 2);
constexpr size_t OFF_WPG = al256(OFF_WOUT + (size_t)DM * DM * 2);
constexpr size_t OFF_WPE = al256(OFF_WPG + (size_t)DM * DM * 2);
constexpr size_t OFF_WGA = al256(OFF_WPE + (size_t)DM * PLE * 2);
constexpr size_t OFF_WGX = al256(OFF_WGA + (size_t)10 * 128 * 128 * 2);
constexpr size_t OFF_BIN = al256(OFF_WGX + (size_t)10 * 128 * 128 * 2);
constexpr size_t OFF_ROPE = al256(OFF_BIN + (size_t)NIN * 4);
constexpr size_t OFF_TOT = al256(OFF_ROPE + (size_t)2 * SEQ * 64 * 4);
constexpr size_t OFF_LSE = al256(OFF_TOT + (size_t)16 * 16 * DRNN * 2 * 4);
constexpr size_t OFF_SSQ = al256(OFF_LSE + (size_t)3 * MROWS * 4 * 4);
constexpr size_t OFF_CTR = al256(OFF_SSQ + (size_t)MROWS * 16 * 4);
constexpr size_t OFF_BAR = al256(OFF_CTR + 256);
constexpr size_t OFF_HN = al256(OFF_BAR + 3456 * 4);
constexpr size_t OFF_PB = al256(OFF_HN + (size_t)MROWS * DM * 2);
constexpr size_t OFF_XR = al256(OFF_PB + (size_t)MROWS * PLE * 2);
constexpr size_t OFF_R = al256(OFF_XR + (size_t)MROWS * DRNN * 2);
constexpr size_t OFF_ZR = OFF_R;
constexpr size_t OFF_ZA = al256(OFF_ZR + (size_t)MROWS * DRNN * 2);
constexpr size_t OFF_G = al256(OFF_ZA + (size_t)MROWS * ATTW * 2);
constexpr size_t OFF_GX = al256(OFF_R + (size_t)MROWS * QKVW * 2);
constexpr size_t WS_END = al256(OFF_GX + (size_t)MROWS * 256 * 2);
static_assert(OFF_G + (size_t)MROWS * 2048 * 2 <= WS_END, "region R too small");
static_assert(WS_END <= (size_t)536870912, "workspace over 512 MiB");

constexpr int GAIN_OFF = 4 * 128 * 272 + 1536;
constexpr int LDS_BYTES = 4 * 128 * 272 + 1536 + 3072 + 16;
constexpr int KS_STRIDE = 272, VT_STRIDE = 528, XC_STRIDE = 272;
constexpr int VT_OFF = 256 * KS_STRIDE;

struct Params {
    const float *x, *p, *norm_mix, *w_in, *b_in, *conv_w, *conv_b, *w_rg_a, *b_rg_a, *w_rg_x, *b_rg_x, *lam, *q_norm, *k_norm, *w_o_rnn, *w_o_att, *w_out, *norm_ple, *w_ple_gate, *b_ple_gate, *w_ple;
    float* out; unsigned char* ws;
};

__device__ __forceinline__ unsigned pk2(float lo, float hi) { unsigned r; asm volatile("v_cvt_pk_bf16_f32 %0, %1, %2" : "=v"(r) : "v"(lo), "v"(hi)); return r; }
__device__ __forceinline__ float bflo(unsigned w) { return __uint_as_float(w << 16); }
__device__ __forceinline__ float bfhi(unsigned w) { return __uint_as_float(w & 0xffff0000u); }
__device__ __forceinline__ float bf2f(bf16_t b) { return __uint_as_float(((unsigned)b) << 16); }
__device__ __forceinline__ float wave_sum(float v) {
#pragma unroll
    for (int o = 1; o < 64; o <<= 1) v += __shfl_xor(v, o);
    return v;
}
__device__ __forceinline__ float sigmoidf_(float v) { return __builtin_amdgcn_rcpf(1.0f + __expf(-v)); }
__device__ __forceinline__ float siluf_(float v) { return v * __builtin_amdgcn_rcpf(1.0f + __expf(-v)); }
#define LDS_WAIT() asm volatile("s_waitcnt lgkmcnt(0)" ::: "memory")

namespace pg8 {
constexpr int BM = 256, BK = 64, HALF = 128, HTB = HALF * BK * 2, STAGE_BYTES = 8 * HTB, NXCD = 8, WGM = 8;
__host__ __device__ __forceinline__ int lds_byte(int r, int c) { const int st = (r >> 4) * 2 + (c >> 5), rr = r & 15, cc = c & 31, ob = rr * 64 + cc * 2; return st * 1024 + (ob ^ (((ob >> 9) & 1) << 5)); }
__host__ __device__ __forceinline__ void stage_rc(int b, int& R, int& C) { const int st = b / 1024, sb = b % 1024, swz = sb ^ (((sb >> 9) & 1) << 5); R = (st >> 1) * 16 + swz / 64; C = (st & 1) * 32 + (swz % 64) / 2; }
__host__ __device__ __forceinline__ int perm32(int rho) { const int n = rho >> 4, i = rho & 15; return 8 * (i >> 2) + 4 * n + (i & 3); }
struct Unit { int pm, pn; };
struct Gemm { const bf16_t* A; const bf16_t* Bt; int M, N, K; };
struct StaticOrder {
    int nM, nN, nwg, G, c;
    __device__ void init(int M, int N, int G_, int c_) { nM = M / BM; nN = N / BM; nwg = nM * nN; G = G_; c = c_; }
    __device__ bool next(int i, Unit& u) const {
        const long L = (long)i * G + c; if (L >= nwg) return false;
        int wgid = (int)L; { const int q = nwg / NXCD, r = nwg % NXCD, xcd = wgid % NXCD, off = wgid / NXCD; wgid = (xcd < r ? xcd * (q + 1) : r * (q + 1) + (xcd - r) * q) + off; }
        const int nig = WGM * nN, gid = wgid / nig, fm = gid * WGM, gsz = (nM - fm) < WGM ? (nM - fm) : WGM;
        u.pm = fm + ((wgid % nig) % gsz); u.pn = (wgid % nig) / gsz; return true;
    }
};

template <class Epi>
__device__ __forceinline__ void gemm_phase(LAS unsigned char* lds, const Gemm g, const StaticOrder& S, const Epi& E) {
    int tid = threadIdx.x; asm volatile("" : "+v"(tid));
    const int wid = __builtin_amdgcn_readfirstlane(tid >> 6), lane = tid & 63, wr = wid >> 2, wc = wid & 3, fr = lane & 15, fq = lane >> 4;
    int K = g.K; asm volatile("" : "+s"(K)); const int nt = K / BK;
    unsigned voffA[2], voffB[2];
#pragma unroll
    for (int i = 0; i < 2; ++i) { int R, C; stage_rc(tid * 16 + i * 8192, R, C); const int Rb = Epi::PERM ? ((R & ~31) + perm32(R & 31)) : R;
        voffA[i] = (unsigned)(R * K + C) * 2u; voffB[i] = (unsigned)(Rb * K + C) * 2u; }
    const size_t kstep = (size_t)(BK * 2);
    const size_t hstep = (size_t)HALF * K * 2;
    const size_t tstep = 2 * hstep;
    const unsigned ldsw = (unsigned)wid * 1024u;
    const int aoff = lds_byte(wr * 64 + fr, fq * 8), boff = lds_byte(wc * 32 + fr, fq * 8);
#define PG8_SA(b, h) (((b) * 2 + (h)) * HTB)
#define PG8_SB(b, h) ((4 + (b) * 2 + (h)) * HTB)
#define PG8_STAGE(bufoff, gbase, voff) do { _Pragma("unroll") for (int _i = 0; _i < 2; ++_i) \
        __builtin_amdgcn_global_load_lds((const unsigned*)((const char*)(gbase) + (voff)[_i]), (LAS unsigned*)(lds + (bufoff) + ldsw + _i * 8192), 16, 0, 0); } while (0)
#define PG8_LDA(dst, b, h) do { _Pragma("unroll") for (int m = 0; m < 4; ++m) _Pragma("unroll") for (int k = 0; k < 2; ++k) dst[m][k] = *(const LAS bf16x8*)(lds + PG8_SA(b, h) + aoff + m * 2048 + k * 1024); } while (0)
#define PG8_LDB(dst, b, h) do { _Pragma("unroll") for (int n = 0; n < 2; ++n) _Pragma("unroll") for (int k = 0; k < 2; ++k) dst[n][k] = *(const LAS bf16x8*)(lds + PG8_SB(b, h) + boff + n * 2048 + k * 1024); } while (0)
#define PG8_MMA(ai, bj, At, Bt) do { __builtin_amdgcn_s_setprio(1); _Pragma("unroll") for (int m = 0; m < 4; ++m) _Pragma("unroll") for (int n = 0; n < 2; ++n) _Pragma("unroll") for (int k = 0; k < 2; ++k) \
        acc[ai][bj][m][n] = __builtin_amdgcn_mfma_f32_16x16x32_bf16(Bt[n][k], At[m][k], acc[ai][bj][m][n], 0, 0, 0); __builtin_amdgcn_s_setprio(0); } while (0)
#define PG8_WAIT_V(n) asm volatile("s_waitcnt vmcnt(" #n ")" ::: "memory")
#define PG8_WAIT_L(n) asm volatile("s_waitcnt lgkmcnt(" #n ")" ::: "memory")
#define PG8_BAR __builtin_amdgcn_s_barrier()
#define PG8_SCHED __builtin_amdgcn_sched_barrier(0)
    Unit cur, nxt; int ui = 0;
    if (!S.next(0, cur)) return;
    f32x4 acc[2][2][4][2];
#pragma unroll
    for (int a = 0; a < 2; ++a)
#pragma unroll
        for (int b = 0; b < 2; ++b)
#pragma unroll
            for (int m = 0; m < 4; ++m)
#pragma unroll
                for (int n = 0; n < 2; ++n) acc[a][b][m][n] = (f32x4){0.f, 0.f, 0.f, 0.f};
    bf16x8 At[4][2], B0[2][2], B1[2][2];
    f32x4 bvp[2][2];
#pragma unroll
    for (int bj = 0; bj < 2; ++bj)
#pragma unroll
        for (int n = 0; n < 2; ++n) bvp[bj][n] = (f32x4){0.f, 0.f, 0.f, 0.f};
    const char* cA = (const char*)g.A + (size_t)cur.pm * tstep; const char* cB = (const char*)g.Bt + (size_t)cur.pn * tstep;
    PG8_STAGE(PG8_SB(0, 0), cB, voffB); PG8_STAGE(PG8_SA(0, 0), cA, voffA); PG8_STAGE(PG8_SB(0, 1), cB + hstep, voffB); PG8_STAGE(PG8_SA(0, 1), cA + hstep, voffA);
    if (wr == 1) PG8_BAR;
    PG8_WAIT_V(4); PG8_BAR;
    PG8_STAGE(PG8_SB(1, 0), cB + kstep, voffB); PG8_STAGE(PG8_SA(1, 0), cA + kstep, voffA); PG8_STAGE(PG8_SB(1, 1), cB + hstep + kstep, voffB);
    PG8_WAIT_V(6); PG8_BAR;
    for (;;) {
        const bool has_next = S.next(ui + 1, nxt);
        const char* nA = has_next ? (const char*)g.A + (size_t)nxt.pm * tstep : cA; const char* nB = has_next ? (const char*)g.Bt + (size_t)nxt.pn * tstep : cB;
        for (int t = 0; t < nt; t += 2) {
            if constexpr (Epi::MID_T > 0) { if (t == Epi::MID_T) E.mid(acc, cur, wr, wc, fr, fq); }
            const bool last = (t == nt - 2);
            if constexpr (Epi::HAS_BIAS) { if (last) { const float* bp = E.bias + cur.pn * 256 + wc * 32 + 8 * fq;
#pragma unroll
                for (int bj = 0; bj < 2; ++bj)
#pragma unroll
                    for (int n = 0; n < 2; ++n) bvp[bj][n] = *(const f32x4*)(bp + bj * 128 + 4 * n); } }
            const char* a1 = cA + (size_t)(t + 1) * kstep;
            const char* a2 = last ? nA : cA + (size_t)(t + 2) * kstep; const char* b2 = last ? nB : cB + (size_t)(t + 2) * kstep;
            const char* a3 = a2 + kstep; const char* b3 = b2 + kstep;
            PG8_LDB(B0, 0, 0); PG8_SCHED; PG8_LDA(At, 0, 0); PG8_STAGE(PG8_SA(1, 1), a1 + hstep, voffA);
            PG8_WAIT_L(8); PG8_BAR; PG8_WAIT_L(0); PG8_MMA(0, 0, At, B0); PG8_BAR; PG8_SCHED;
            PG8_LDB(B1, 0, 1); PG8_STAGE(PG8_SB(0, 0), b2, voffB);
            PG8_BAR; PG8_WAIT_L(0); PG8_MMA(0, 1, At, B1); PG8_BAR;
            PG8_LDA(At, 0, 1); PG8_STAGE(PG8_SA(0, 0), a2, voffA);
            PG8_BAR; PG8_WAIT_L(0); PG8_MMA(1, 0, At, B0); PG8_BAR; PG8_SCHED;
            PG8_STAGE(PG8_SB(0, 1), b2 + hstep, voffB);
            PG8_WAIT_V(6); PG8_BAR; PG8_MMA(1, 1, At, B1); PG8_BAR;
            PG8_LDB(B0, 1, 0); PG8_SCHED; PG8_LDA(At, 1, 0); PG8_STAGE(PG8_SA(0, 1), a2 + hstep, voffA);
            PG8_WAIT_L(8); PG8_BAR; PG8_WAIT_L(0); PG8_MMA(0, 0, At, B0); PG8_BAR; PG8_SCHED;
            PG8_LDB(B1, 1, 1); PG8_STAGE(PG8_SB(1, 0), b3, voffB);
            PG8_BAR; PG8_WAIT_L(0); PG8_MMA(0, 1, At, B1); PG8_BAR;
            PG8_LDA(At, 1, 1); PG8_STAGE(PG8_SA(1, 0), a3, voffA);
            PG8_BAR; PG8_WAIT_L(0); PG8_MMA(1, 0, At, B0); PG8_BAR; PG8_SCHED;
            PG8_STAGE(PG8_SB(1, 1), b3 + hstep, voffB);
            PG8_WAIT_V(6); PG8_BAR; PG8_MMA(1, 1, At, B1); PG8_BAR;
        }
        if constexpr (Epi::HAS_BIAS) E(acc, cur, wr, wc, fr, fq, bvp); else E(acc, cur, wr, wc, fr, fq);
        if (!has_next) break;
#pragma unroll
        for (int a = 0; a < 2; ++a)
#pragma unroll
            for (int b = 0; b < 2; ++b)
#pragma unroll
                for (int m = 0; m < 4; ++m)
#pragma unroll
                    for (int n = 0; n < 2; ++n) acc[a][b][m][n] = (f32x4){0.f, 0.f, 0.f, 0.f};
        cur = nxt; cA = nA; cB = nB; ++ui;
    }
    PG8_WAIT_V(0);
    if (wr == 0) PG8_BAR;
    PG8_BAR;
#undef PG8_SA
#undef PG8_SB
#undef PG8_STAGE
#undef PG8_LDA
#undef PG8_LDB
#undef PG8_MMA
#undef PG8_WAIT_V
#undef PG8_WAIT_L
#undef PG8_BAR
#undef PG8_SCHED
}
}
using pg8::Unit;

template <int WHICH> struct EpiProj {
    static constexpr bool PERM = true; static constexpr int MID_T = 0; static constexpr bool HAS_BIAS = true;
    const float* bias;
    unsigned char* ws; const void* ogp;
    __device__ __forceinline__ void operator()(const f32x4 (&acc)[2][2][4][2], const Unit& u, int wr, int wc, int fr, int fq, const f32x4 (&bv)[2][2]) const {
        constexpr int pnb0 = 5, pnb1 = WHICH == 0 ? 23 : 7;
        const int t = u.pn < pnb0 ? 0 : (u.pn < pnb1 ? 1 : 2);
        const size_t off = WHICH == 0 ? (t == 0 ? OFF_XR : (t == 1 ? OFF_R : OFF_GX)) : (t == 2 ? OFF_G : OFF_ZR);
        const int ld = WHICH == 0 ? (t == 0 ? DRNN : (t == 1 ? QKVW : 256)) : (t == 2 ? 2048 : 1792);
        const int cbase = WHICH == 1 ? (t == 1 ? DRNN : (t == 2 ? 256 : 0)) : 0;
        bf16_t* base = (bf16_t*)(ws + off);
        const int colt = (u.pn - (t == 0 ? 0 : (t == 1 ? pnb0 : pnb1))) * 256;
        const int row0 = u.pm * 256 + wr * 64 + fr, col0 = colt + wc * 32 + 8 * fq, bcol0 = u.pn * 256 + wc * 32 + 8 * fq;
        const bool sig = (WHICH == 0 && t == 2) || (WHICH == 1 && t == 2);
        if (WHICH == 1 && t == 0) {
#pragma unroll
            for (int ai = 0; ai < 2; ++ai) {
                u32x4 hh[4][2];
#pragma unroll
                for (int m = 0; m < 4; ++m)
#pragma unroll
                    for (int bj = 0; bj < 2; ++bj) hh[m][bj] = *(const u32x4*)((const bf16_t*)(ws + OFF_XR) + (size_t)(row0 + ai * 128 + m * 16) * DRNN + col0 + bj * 128);
#pragma unroll
                for (int m = 0; m < 4; ++m) { bf16_t* rowp = base + (size_t)(row0 + ai * 128 + m * 16) * ld + col0 + cbase;
#pragma unroll
                    for (int bj = 0; bj < 2; ++bj) { const f32x4 v0 = acc[ai][bj][m][0] + bv[bj][0], v1 = acc[ai][bj][m][1] + bv[bj][1]; const u32x4 q = hh[m][bj];
                        u32x4 w; w.x = pk2(siluf_(v0[0]) * bflo(q.x), siluf_(v0[1]) * bfhi(q.x)); w.y = pk2(siluf_(v0[2]) * bflo(q.y), siluf_(v0[3]) * bfhi(q.y));
                        w.z = pk2(siluf_(v1[0]) * bflo(q.z), siluf_(v1[1]) * bfhi(q.z)); w.w = pk2(siluf_(v1[2]) * bflo(q.w), siluf_(v1[3]) * bfhi(q.w));
                        *(u32x4*)(rowp + bj * 128) = w; } }
                asm volatile("" ::: "memory"); }
            return; }
#pragma unroll
        for (int ai = 0; ai < 2; ++ai)
#pragma unroll
        for (int mh = 0; mh < 2; ++mh) {
            f32x4 mul[2][2][2];
            if (WHICH == 1 && t == 1) {
                const float* LSE = (const float*)(ws + OFF_LSE); const bf16_t* OG = (const bf16_t*)ogp;
                u32x4 og[2][2][3]; float ls[2][2][3];
#pragma unroll
                for (int mm = 0; mm < 2; ++mm)
#pragma unroll
                    for (int bj = 0; bj < 2; ++bj) { const size_t row = (size_t)(row0 + ai * 128 + (2 * mh + mm) * 16); const int col = col0 + bj * 128, hd = col >> 7;
#pragma unroll
                        for (int gq = 0; gq < 3; ++gq) { og[mm][bj][gq] = *(const u32x4*)(OG + ((size_t)gq * MROWS + row) * ATTW + col); ls[mm][bj][gq] = LSE[((size_t)gq * MROWS + row) * 4 + hd]; } }
#pragma unroll
                for (int mm = 0; mm < 2; ++mm)
#pragma unroll
                    for (int bj = 0; bj < 2; ++bj) { const float l0 = ls[mm][bj][0], l1 = ls[mm][bj][1], l2 = ls[mm][bj][2];
                        const float mxl = fmaxf(l0, fmaxf(l1, l2)); float w0 = __expf(l0 - mxl), w1 = __expf(l1 - mxl), w2 = __expf(l2 - mxl); const float inv = __builtin_amdgcn_rcpf(w0 + w1 + w2); w0 *= inv; w1 *= inv; w2 *= inv;
                        const u32x4 o0 = og[mm][bj][0], o1 = og[mm][bj][1], o2 = og[mm][bj][2];
                        mul[mm][bj][0] = (f32x4){w0 * bflo(o0.x) + w1 * bflo(o1.x) + w2 * bflo(o2.x), w0 * bfhi(o0.x) + w1 * bfhi(o1.x) + w2 * bfhi(o2.x), w0 * bflo(o0.y) + w1 * bflo(o1.y) + w2 * bflo(o2.y), w0 * bfhi(o0.y) + w1 * bfhi(o1.y) + w2 * bfhi(o2.y)};
                        mul[mm][bj][1] = (f32x4){w0 * bflo(o0.z) + w1 * bflo(o1.z) + w2 * bflo(o2.z), w0 * bfhi(o0.z) + w1 * bfhi(o1.z) + w2 * bfhi(o2.z), w0 * bflo(o0.w) + w1 * bflo(o1.w) + w2 * bflo(o2.w), w0 * bfhi(o0.w) + w1 * bfhi(o1.w) + w2 * bfhi(o2.w)}; } }
            if (sig) {
                const int gj = WHICH == 0 ? 0 : u.pn - 6;
                bf16_t* Rb = WHICH == 0 ? (bf16_t*)(ws + OFF_GX) : (bf16_t*)(ws + OFF_G); const int ldg = WHICH == 0 ? 128 : 1024;
                bf16_t* Gb = Rb + (size_t)MROWS * ldg; const int gcol = (WHICH == 0 ? 0 : gj * 128) + wc * 32 + 8 * fq;
#pragma unroll
                for (int mm = 0; mm < 2; ++mm) { const int m = 2 * mh + mm; const size_t row = (size_t)(row0 + ai * 128 + m * 16);
                    u32x4 wr_, wg_; float rr[8], gg[8];
#pragma unroll
                    for (int n = 0; n < 2; ++n)
#pragma unroll
                        for (int j = 0; j < 4; ++j) { const float a0 = acc[ai][0][m][n][j] + bv[0][n][j], a1 = acc[ai][1][m][n][j] + bv[1][n][j];
                            const float d0 = 1.0f + __expf(-a0), d1 = 1.0f + __expf(-a1);
                            gg[4 * n + j] = __builtin_amdgcn_rcpf(d1); rr[4 * n + j] = d1 * __builtin_amdgcn_rcpf(d0); }
                    wr_.x = pk2(rr[0], rr[1]); wr_.y = pk2(rr[2], rr[3]); wr_.z = pk2(rr[4], rr[5]); wr_.w = pk2(rr[6], rr[7]);
                    wg_.x = pk2(gg[0], gg[1]); wg_.y = pk2(gg[2], gg[3]); wg_.z = pk2(gg[4], gg[5]); wg_.w = pk2(gg[6], gg[7]);
                    *(u32x4*)(Rb + row * ldg + gcol) = wr_; *(u32x4*)(Gb + row * ldg + gcol) = wg_; }
                continue; }
#pragma unroll
            for (int mm = 0; mm < 2; ++mm) { const int m = 2 * mh + mm; bf16_t* rowp = base + (size_t)(row0 + ai * 128 + m * 16) * ld + col0 + cbase;
#pragma unroll
                for (int bj = 0; bj < 2; ++bj) { f32x4 v0 = acc[ai][bj][m][0] + bv[bj][0], v1 = acc[ai][bj][m][1] + bv[bj][1];
                    if (WHICH == 1) {
#pragma unroll
                        for (int j = 0; j < 4; ++j) { v0[j] = siluf_(v0[j]) * mul[mm][bj][0][j]; v1[j] = siluf_(v1[j]) * mul[mm][bj][1][j]; } }
                    u32x4 w; w.x = pk2(v0[0], v0[1]); w.y = pk2(v0[2], v0[3]); w.z = pk2(v1[0], v1[1]); w.w = pk2(v1[2], v1[3]);
                    *(u32x4*)(rowp + bj * 128) = w; } }
            if (WHICH == 1) asm volatile("" ::: "memory"); }
    }
};
struct EpiMergeFused {
    static constexpr bool PERM = true; static constexpr int MID_T = 20; static constexpr bool HAS_BIAS = false;
    const bf16_t* G; bf16_t* MG; const bf16_t* GX;
    __device__ __forceinline__ void mid(f32x4 (&acc)[2][2][4][2], const Unit& u, int wr, int wc, int fr, int fq) const {
        int frx = fr, fqx = fq; asm volatile("" : "+v"(frx), "+v"(fqx));
        const int row0 = u.pm * 256 + wr * 64 + frx, col0 = u.pn * 256 + wc * 32 + 8 * fqx;
        u32x4 rq[2][4][2];
#pragma unroll
        for (int ai = 0; ai < 2; ++ai)
#pragma unroll
            for (int m = 0; m < 4; ++m)
#pragma unroll
                for (int bj = 0; bj < 2; ++bj) { const size_t row = (size_t)(row0 + ai * 128 + m * 16); const int col = col0 + bj * 128;
                    rq[ai][m][bj] = *(const u32x4*)((bj == 0 && u.pn == 0) ? GX + row * 128 + col : G + row * 1024 + col); }
#pragma unroll
        for (int ai = 0; ai < 2; ++ai)
#pragma unroll
            for (int m = 0; m < 4; ++m)
#pragma unroll
                for (int bj = 0; bj < 2; ++bj) { const u32x4 a = rq[ai][m][bj];
                    acc[ai][bj][m][0] *= (f32x4){bflo(a.x), bfhi(a.x), bflo(a.y), bfhi(a.y)}; acc[ai][bj][m][1] *= (f32x4){bflo(a.z), bfhi(a.z), bflo(a.w), bfhi(a.w)}; }
        asm volatile("" ::: "memory");
    }
    __device__ __forceinline__ void operator()(const f32x4 (&acc)[2][2][4][2], const Unit& u, int wr, int wc, int fr, int fq) const {
        const int row0 = u.pm * 256 + wr * 64 + fr, col0 = u.pn * 256 + wc * 32 + 8 * fq;
        const bf16_t* G1 = G + (size_t)MROWS * 1024; const bf16_t* GX1 = GX + (size_t)MROWS * 128;
        u32x4 gg[2][4][2];
#pragma unroll
        for (int ai = 0; ai < 2; ++ai)
#pragma unroll
            for (int m = 0; m < 4; ++m)
#pragma unroll
                for (int bj = 0; bj < 2; ++bj) { const size_t row = (size_t)(row0 + ai * 128 + m * 16); const int col = col0 + bj * 128;
                    gg[ai][m][bj] = *(const u32x4*)((bj == 0 && u.pn == 0) ? GX1 + row * 128 + col : G1 + row * 1024 + col); }
#pragma unroll
        for (int ai = 0; ai < 2; ++ai)
#pragma unroll
            for (int m = 0; m < 4; ++m) { const size_t row = (size_t)(row0 + ai * 128 + m * 16);
#pragma unroll
                for (int bj = 0; bj < 2; ++bj) { const int col = col0 + bj * 128; const u32x4 q = gg[ai][m][bj];
                    const f32x4 a0 = acc[ai][bj][m][0], a1 = acc[ai][bj][m][1];
                    u32x4 w; w.x = pk2(a0[0] * bflo(q.x), a0[1] * bfhi(q.x)); w.y = pk2(a0[2] * bflo(q.y), a0[3] * bfhi(q.y));
                    w.z = pk2(a1[0] * bflo(q.z), a1[1] * bfhi(q.z)); w.w = pk2(a1[2] * bflo(q.w), a1[3] * bfhi(q.w));
                    *(u32x4*)(MG + row * 1024 + col) = w; } }
    }
};
struct EpiX1 {
    static constexpr bool PERM = true; static constexpr int MID_T = 0; static constexpr bool HAS_BIAS = false;
    const float* x; float* X1; bf16_t* X1B; float* SSQ;
    __device__ __forceinline__ void operator()(const f32x4 (&acc)[2][2][4][2], const Unit& u, int wr, int wc, int fr, int fq) const {
        const int row0 = u.pm * 256 + wr * 64 + fr, col0 = u.pn * 256 + wc * 32 + 8 * fq;
#pragma unroll
        for (int ai = 0; ai < 2; ++ai) {
            f32x4 xv[4][2][2];
#pragma unroll
            for (int m = 0; m < 4; ++m)
#pragma unroll
                for (int bj = 0; bj < 2; ++bj) { const size_t o = (size_t)(row0 + ai * 128 + m * 16) * 1024 + col0 + bj * 128; xv[m][bj][0] = *(const f32x4*)(x + o); xv[m][bj][1] = *(const f32x4*)(x + o + 4); }
#pragma unroll
            for (int m = 0; m < 4; ++m) { const size_t row = (size_t)(row0 + ai * 128 + m * 16); float ss = 0.f;
#pragma unroll
                for (int bj = 0; bj < 2; ++bj) { const size_t o = row * 1024 + col0 + bj * 128;
                    const f32x4 v0 = xv[m][bj][0] + acc[ai][bj][m][0], v1 = xv[m][bj][1] + acc[ai][bj][m][1];
                    u32x4 w; w.x = pk2(v0[0], v0[1]); w.y = pk2(v0[2], v0[3]); w.z = pk2(v1[0], v1[1]); w.w = pk2(v1[2], v1[3]);
                    *(u32x4*)(X1B + o) = w;
                    ss += (v0[0] * v0[0] + v0[1] * v0[1]) + (v0[2] * v0[2] + v0[3] * v0[3]) + (v1[0] * v1[0] + v1[1] * v1[1]) + (v1[2] * v1[2] + v1[3] * v1[3]); }
                ss += __shfl_xor(ss, 16); ss += __shfl_xor(ss, 32);
                if (fq == 0) SSQ[row * 16 + u.pn * 4 + wc] = ss; }
            asm volatile("" ::: "memory"); }
    }
};
struct EpiPe {
    static constexpr bool PERM = true; static constexpr int MID_T = 0; static constexpr bool HAS_BIAS = false;
    bf16_t* PE; const float* SSQ; float* RSTD;
    __device__ __forceinline__ void operator()(const f32x4 (&acc)[2][2][4][2], const Unit& u, int wr, int wc, int fr, int fq) const {
        const int row0 = u.pm * 256 + wr * 64 + fr, col0 = u.pn * 256 + wc * 32 + 8 * fq;
#pragma unroll
        for (int ai = 0; ai < 2; ++ai) {
            f32x4 sv[4][4];
#pragma unroll
            for (int m = 0; m < 4; ++m)
#pragma unroll
                for (int q = 0; q < 4; ++q) sv[m][q] = *(const f32x4*)(SSQ + (size_t)(row0 + ai * 128 + m * 16) * 16 + 4 * q);
#pragma unroll
            for (int m = 0; m < 4; ++m) { const f32x4 st = (sv[m][0] + sv[m][1]) + (sv[m][2] + sv[m][3]);
                RSTD[row0 + ai * 128 + m * 16] = rsqrtf(((st[0] + st[1]) + (st[2] + st[3])) * (1.0f / 1024.0f) + EPS); } }
#pragma unroll
        for (int ai = 0; ai < 2; ++ai)
#pragma unroll
            for (int m = 0; m < 4; ++m) { const size_t row = (size_t)(row0 + ai * 128 + m * 16);
#pragma unroll
                for (int bj = 0; bj < 2; ++bj) { const size_t o = row * 1024 + col0 + bj * 128; const f32x4 a0 = acc[ai][bj][m][0], a1 = acc[ai][bj][m][1];
                    u32x4 w; w.x = pk2(a0[0], a0[1]); w.y = pk2(a0[2], a0[3]); w.z = pk2(a1[0], a1[1]); w.w = pk2(a1[2], a1[3]);
                    *(u32x4*)(PE + o) = w; } }
    }
};
struct EpiFinal {
    static constexpr bool PERM = true; static constexpr int MID_T = 0; static constexpr bool HAS_BIAS = false;
    const bf16_t* PE; const float* RSTD; const float* bias; float* out; const bf16_t* X1B;
    __device__ __forceinline__ void operator()(const f32x4 (&acc)[2][2][4][2], const Unit& u, int wr, int wc, int fr, int fq) const {
        const int row0 = u.pm * 256 + wr * 64 + fr, col0 = u.pn * 256 + wc * 32 + 8 * fq;
        f32x4 bv[2][2];
#pragma unroll
        for (int bj = 0; bj < 2; ++bj)
#pragma unroll
            for (int n = 0; n < 2; ++n) bv[bj][n] = *(const f32x4*)(bias + col0 + bj * 128 + 4 * n);
#pragma unroll
        for (int ai = 0; ai < 2; ++ai) {
            float rs[4]; u32x4 pw[4][2], xw[4][2];
#pragma unroll
            for (int m = 0; m < 4; ++m) { rs[m] = RSTD[row0 + ai * 128 + m * 16];
#pragma unroll
                for (int bj = 0; bj < 2; ++bj) { const size_t o = (size_t)(row0 + ai * 128 + m * 16) * 1024 + col0 + bj * 128;
                    pw[m][bj] = *(const u32x4*)(PE + o); xw[m][bj] = *(const u32x4*)(X1B + o); } }
#pragma unroll
            for (int m = 0; m < 4; ++m)
#pragma unroll
                for (int bj = 0; bj < 2; ++bj) { const size_t o = (size_t)(row0 + ai * 128 + m * 16) * 1024 + col0 + bj * 128;
                    const f32x4 a0 = acc[ai][bj][m][0] * rs[m] + bv[bj][0], a1 = acc[ai][bj][m][1] * rs[m] + bv[bj][1];
                    const u32x4 p = pw[m][bj], xq = xw[m][bj];
                    f32x4 r0, r1;
                    r0[0] = bflo(xq.x) + sigmoidf_(a0[0]) * bflo(p.x); r0[1] = bfhi(xq.x) + sigmoidf_(a0[1]) * bfhi(p.x); r0[2] = bflo(xq.y) + sigmoidf_(a0[2]) * bflo(p.y); r0[3] = bfhi(xq.y) + sigmoidf_(a0[3]) * bfhi(p.y);
                    r1[0] = bflo(xq.z) + sigmoidf_(a1[0]) * bflo(p.z); r1[1] = bfhi(xq.z) + sigmoidf_(a1[1]) * bfhi(p.z); r1[2] = bflo(xq.w) + sigmoidf_(a1[2]) * bflo(p.w); r1[3] = bfhi(xq.w) + sigmoidf_(a1[3]) * bfhi(p.w);
                    *(f32x4*)(out + o) = r0; *(f32x4*)(out + o + 4) = r1; }
            asm volatile("" ::: "memory"); }
    }
};

__device__ __forceinline__ void transpose_item(const float* W, int N, bf16_t* WT, int ldk, int k0, int n0, int drow0, const float* kscale, LAS float* scr, int lane) {
    float tv[32];
#pragma unroll
    for (int i = 0; i < 32; ++i) { const int kk = 2 * i + (lane >> 5); tv[i] = W[(size_t)(k0 + kk) * N + n0 + (lane & 31)]; }
#pragma unroll
    for (int i = 0; i < 32; ++i) { const int kk = 2 * i + (lane >> 5); float v = tv[i]; if (kscale) v *= kscale[k0 + kk]; scr[kk * 33 + (lane & 31)] = v; }
    LDS_WAIT();
    const int c = lane & 7;
#pragma unroll
    for (int j = 0; j < 4; ++j) { const int n = (lane >> 3) + 8 * j; const LAS float* s = scr + (8 * c) * 33 + n;
        u32x4 o; o.x = pk2(s[0 * 33], s[1 * 33]); o.y = pk2(s[2 * 33], s[3 * 33]); o.z = pk2(s[4 * 33], s[5 * 33]); o.w = pk2(s[6 * 33], s[7 * 33]);
        *(u32x4*)(WT + (size_t)(drow0 + n) * ldk + k0 + 8 * c) = o; }
    LDS_WAIT();
}
__device__ __forceinline__ int perm_col(int n) {
    if (n < 1280) return n;
    if (n < 2560) return n + 4864;
    if (n < 7168) return n - 1280;
    if (n < 7680) return n + 256;
    const int gi = n - 7680, which = gi >> 10, c = gi & 1023, gpos = (c >> 7) * 256 + which * 128 + (c & 127);
    return gpos < 256 ? 5888 + gpos : 7936 + (gpos - 256);
}

__device__ __forceinline__ void phase0(const Params& P, LAS unsigned char* L) {
    int tid = threadIdx.x; asm volatile("" : "+v"(tid));
    const int wid = tid >> 6, lane = tid & 63;
    const int gw = blockIdx.x * 8 + wid, NGW = gridDim.x * 8;
    const size_t gt = (size_t)blockIdx.x * 512 + tid, NGT = (size_t)gridDim.x * 512;
    unsigned char* ws = P.ws;
    { bf16_t* HN = (bf16_t*)(ws + OFF_HN);
      f32x4 gn[4];
#pragma unroll
      for (int j = 0; j < 4; ++j) gn[j] = *((const f32x4*)P.norm_mix + lane + 64 * j);
      for (int row = gw; row < MROWS; row += 4 * NGW) {
          f32x4 v[4][4];
#pragma unroll
          for (int r = 0; r < 4; ++r) { const int rr = row + r * NGW < MROWS ? row + r * NGW : row; const f32x4* xr = (const f32x4*)(P.x + (size_t)rr * DM) + lane;
#pragma unroll
              for (int j = 0; j < 4; ++j) v[r][j] = xr[64 * j]; }
#pragma unroll
          for (int r = 0; r < 4; ++r) { float s = 0.f;
#pragma unroll
              for (int j = 0; j < 4; ++j) s += (v[r][j][0] * v[r][j][0] + v[r][j][1] * v[r][j][1]) + (v[r][j][2] * v[r][j][2] + v[r][j][3] * v[r][j][3]);
              const float rstd = rsqrtf(wave_sum(s) * (1.0f / DM) + EPS);
              if (row + r * NGW < MROWS) { u32x2* o8 = (u32x2*)(HN + (size_t)(row + r * NGW) * DM) + lane;
#pragma unroll
                  for (int j = 0; j < 4; ++j) { u32x2 w; w.x = pk2(v[r][j][0] * rstd * gn[j][0], v[r][j][1] * rstd * gn[j][1]); w.y = pk2(v[r][j][2] * rstd * gn[j][2], v[r][j][3] * rstd * gn[j][3]); o8[64 * j] = w; } } }
      } }
    { bf16_t* PB = (bf16_t*)(ws + OFF_PB); const size_t NI = (size_t)MROWS * PLE / 8;
      for (size_t i = gt; i < NI; i += 4 * NGT) { f32x4 av[4], bw[4];
#pragma unroll
          for (int r = 0; r < 4; ++r) { const size_t ii = i + r * NGT < NI ? i + r * NGT : i; av[r] = *((const f32x4*)P.p + 2 * ii); bw[r] = *((const f32x4*)P.p + 2 * ii + 1); }
#pragma unroll
          for (int r = 0; r < 4; ++r) if (i + r * NGT < NI) { u32x4 w; w.x = pk2(av[r][0], av[r][1]); w.y = pk2(av[r][2], av[r][3]); w.z = pk2(bw[r][0], bw[r][1]); w.w = pk2(bw[r][2], bw[r][3]); *((u32x4*)PB + i + r * NGT) = w; } } }
    { LAS float* scr = (LAS float*)(L + wid * 8448);
      constexpr int I0 = 16 * 304, I1 = 20 * 32, I2 = 8 * 32, I3 = 16 * 32, I4 = 16 * 32, I5 = 4 * 32, I6 = 80, I7 = 80;
      constexpr int NIT = I0 + I1 + I2 + I3 + I4 + I5 + I6 + I7;
      for (int it = gw; it < NIT; it += NGW) {
          int r = it;
          if (r < I0) { const int kb = r / 304, nb = r % 304; transpose_item(P.w_in, NIN, (bf16_t*)(ws + OFF_WIN), DM, 64 * kb, 32 * nb, perm_col(32 * nb), nullptr, scr, lane); continue; } r -= I0;
          if (r < I1) { const int kb = r / 32, nb = r % 32; transpose_item(P.w_o_rnn, DM, (bf16_t*)(ws + OFF_WR), 1792, 64 * kb, 32 * nb, 32 * nb, nullptr, scr, lane); continue; } r -= I1;
          if (r < I2) { const int kb = r / 32, nb = r % 32; transpose_item(P.w_o_att, DM, (bf16_t*)(ws + OFF_WR) + DRNN, 1792, 64 * kb, 32 * nb, 32 * nb, nullptr, scr, lane); continue; } r -= I2;
          if (r < I3) { const int kb = r / 32, nb = r % 32; transpose_item(P.w_out, DM, (bf16_t*)(ws + OFF_WOUT), DM, 64 * kb, 32 * nb, 32 * nb, nullptr, scr, lane); continue; } r -= I3;
          if (r < I4) { const int kb = r / 32, nb = r % 32; transpose_item(P.w_ple_gate, DM, (bf16_t*)(ws + OFF_WPG), DM, 64 * kb, 32 * nb, 32 * nb, P.norm_ple, scr, lane); continue; } r -= I4;
          if (r < I5) { const int kb = r / 32, nb = r % 32; transpose_item(P.w_ple, DM, (bf16_t*)(ws + OFF_WPE), PLE, 64 * kb, 32 * nb, 32 * nb, nullptr, scr, lane); continue; } r -= I5;
          if (r < I6) { const int mt = r / 8, q = r % 8, kb = q / 4, nb = q % 4; transpose_item(P.w_rg_a + (size_t)mt * 16384, 128, (bf16_t*)(ws + OFF_WGA) + (size_t)mt * 16384, 128, 64 * kb, 32 * nb, 32 * nb, nullptr, scr, lane); continue; } r -= I6;
          { const int mt = r / 8, q = r % 8, kb = q / 4, nb = q % 4; transpose_item(P.w_rg_x + (size_t)mt * 16384, 128, (bf16_t*)(ws + OFF_WGX) + (size_t)mt * 16384, 128, 64 * kb, 32 * nb, 32 * nb, nullptr, scr, lane); }
      } }
    { float* BIN = (float*)(ws + OFF_BIN);
      for (size_t i = gt; i < (size_t)NIN; i += NGT) BIN[perm_col((int)i)] = P.b_in[i];
      float* RC = (float*)(ws + OFF_ROPE); float* RS = RC + SEQ * 64;
      for (size_t i = gt; i < (size_t)SEQ * 64; i += NGT) { const int pos = (int)(i >> 6), j = (int)(i & 63);
          const float inv_freq = (float)exp2(-(double)j * (13.287712379549449 / 64.0));
          const float angf = (float)pos * inv_freq; const double ang = (double)angf; const double k = rint(ang * 0.15915494309189535);
          const float rr = (float)(ang - k * 6.283185307179586);
          RC[i] = __cosf(rr); RS[i] = __sinf(rr); } }
}

typedef float f32x2 __attribute__((ext_vector_type(2)));
__device__ __forceinline__ void norm_rope(u32x4 (&raw)[4], const LAS float* gain_fq, const f32x2 (&cs)[2][4], const f32x2 (&sn)[2][4], float scale) {
    f32x2 v[4][4]; f32x2 ss2 = (f32x2){0.f, 0.f};
#pragma unroll
    for (int kk = 0; kk < 4; ++kk)
#pragma unroll
        for (int i = 0; i < 4; ++i) { const unsigned w = raw[kk][i]; v[kk][i] = (f32x2){bflo(w), bfhi(w)}; ss2 = v[kk][i] * v[kk][i] + ss2; }
    float ss = ss2.x + ss2.y;
    ss += __shfl_xor(ss, 16); ss += __shfl_xor(ss, 32);
    const float rstd = rsqrtf(ss * (1.0f / 128.0f) + EPS) * scale;
#pragma unroll
    for (int kk = 0; kk < 4; ++kk) { const f32x4 g0 = *(const LAS f32x4*)(gain_fq + kk * 32), g1 = *(const LAS f32x4*)(gain_fq + kk * 32 + 4);
        v[kk][0] *= (f32x2){g0[0], g0[1]}; v[kk][1] *= (f32x2){g0[2], g0[3]}; v[kk][2] *= (f32x2){g1[0], g1[1]}; v[kk][3] *= (f32x2){g1[2], g1[3]}; }
#pragma unroll
    for (int kk = 0; kk < 2; ++kk)
#pragma unroll
        for (int i = 0; i < 4; ++i) { const f32x2 cc = cs[kk][i] * rstd, sc = sn[kk][i] * rstd; const f32x2 t1 = v[kk][i], t2 = v[kk + 2][i];
            v[kk][i] = t1 * cc - t2 * sc; v[kk + 2][i] = t2 * cc + t1 * sc; }
#pragma unroll
    for (int kk = 0; kk < 4; ++kk)
#pragma unroll
        for (int i = 0; i < 4; ++i) raw[kk][i] = pk2(v[kk][i].x, v[kk][i].y);
}

__device__ __forceinline__ void attn_seq(const Params& P, LAS unsigned char* L, int u, unsigned* ctr, LAS int* bc) {
    int nxt = 0;
    int tid = threadIdx.x; asm volatile("" : "+v"(tid));
    const int wid = tid >> 6, lane = tid & 63, fr = lane & 15, fq = lane >> 4;
    int g, b, h, c, nblk;
    if (u < 64) { g = 0; b = u >> 2; h = u & 3; c = 0; nblk = 16; }
    else if (u < 320) { const int r = u - 64; g = 1; b = r >> 4; h = (r >> 2) & 3; c = r & 3; nblk = 4; }
    else { const int r = u - 320; g = 2; b = r >> 6; h = (r >> 4) & 3; c = r & 15; nblk = 1; }
    const int dil = 1 << (2 * g);
    const bf16_t* QKV = (const bf16_t*)(P.ws + OFF_R);
    const int qcol = g * 1536 + h * 128;
    const size_t brow = (size_t)b * SEQ;
    const LAS float* gl = (const LAS float*)(L + GAIN_OFF) + g * 256;
    const LAS float* kgain = gl + fq * 8; const LAS float* qgain = gl + 128 + fq * 8;
    f32x2 frev[2][4];
#pragma unroll
    for (int kk = 0; kk < 2; ++kk)
#pragma unroll
        for (int i = 0; i < 4; ++i) { const float j0 = (float)(kk * 32 + fq * 8 + 2 * i);
            frev[kk][i] = (f32x2){__builtin_amdgcn_exp2f(-j0 * (13.287712379549449f / 64.0f)) * 0.15915494309189535f, __builtin_amdgcn_exp2f(-(j0 + 1.0f) * (13.287712379549449f / 64.0f)) * 0.15915494309189535f}; }
    const int dg = (lane >> 4) + 4 * (wid & 3), kg = (lane & 15) + 16 * (wid >> 2);
    u32x4 qraw[4], kraw[4], vraw[4];
    { const bf16_t* qp = QKV + (brow + (size_t)(16 * wid + fr) * dil + c) * QKVW + qcol + fq * 8;
#pragma unroll
      for (int kk = 0; kk < 4; ++kk) { qraw[kk] = *(const u32x4*)(qp + kk * 32); kraw[kk] = *(const u32x4*)(qp + 512 + kk * 32); }
#pragma unroll
      for (int i = 0; i < 4; ++i) vraw[i] = *(const u32x4*)(QKV + (brow + (size_t)(4 * kg + i) * dil + c) * QKVW + qcol + 1024 + dg * 8); }
    for (int n = 0; n < nblk; ++n) {
        const int slot = n & 1, kx = slot ? 0 : 8;
        const int sq = (128 * n + 16 * wid + fr) * dil + c;
        f32x2 cs[2][4], sn[2][4];
#pragma unroll
        for (int kk = 0; kk < 2; ++kk)
#pragma unroll
            for (int i = 0; i < 4; ++i) { const f32x2 rv = frev[kk][i] * (float)sq; const float r0 = __builtin_amdgcn_fractf(rv.x), r1 = __builtin_amdgcn_fractf(rv.y);
                cs[kk][i] = (f32x2){__builtin_amdgcn_cosf(r0), __builtin_amdgcn_cosf(r1)}; sn[kk][i] = (f32x2){__builtin_amdgcn_sinf(r0), __builtin_amdgcn_sinf(r1)}; }
        norm_rope(kraw, kgain, cs, sn, 1.0f);
#pragma unroll
        for (int kk = 0; kk < 4; ++kk) *(LAS u32x4*)(L + (slot * 128 + 16 * wid + fr) * KS_STRIDE + (kk * 32 + fq * 8) * 2) = kraw[kk];
#pragma unroll
        for (int d = 0; d < 8; ++d) { u32x2 o;
            o.x = __builtin_amdgcn_perm(vraw[1][d >> 1], vraw[0][d >> 1], (d & 1) ? 0x07060302u : 0x05040100u);
            o.y = __builtin_amdgcn_perm(vraw[3][d >> 1], vraw[2][d >> 1], (d & 1) ? 0x07060302u : 0x05040100u);
            *(LAS u32x2*)(L + VT_OFF + (8 * dg + d) * VT_STRIDE + (slot * 128 + 4 * kg) * 2) = o;
            if (n == 0) *(LAS u32x2*)(L + VT_OFF + (8 * dg + d) * VT_STRIDE + ((slot ^ 1) * 128 + 4 * kg) * 2) = (u32x2){0u, 0u}; }
        norm_rope(qraw, qgain, cs, sn, 0.08838834764831845f * 1.4426950408889634f);
        bf16x8 qf[4];
#pragma unroll
        for (int kk = 0; kk < 4; ++kk) qf[kk] = __builtin_bit_cast(bf16x8, qraw[kk]);
        asm volatile("s_waitcnt lgkmcnt(0)" ::: "memory"); __builtin_amdgcn_s_barrier(); asm volatile("" ::: "memory");
        if (n + 1 == nblk && threadIdx.x == 0) nxt = (int)atomicAdd(ctr, 1u);
        if (n + 1 < nblk) { const bf16_t* qp = QKV + (brow + (size_t)(128 * (n + 1) + 16 * wid + fr) * dil + c) * QKVW + qcol + fq * 8;
#pragma unroll
            for (int kk = 0; kk < 4; ++kk) { qraw[kk] = *(const u32x4*)(qp + kk * 32); kraw[kk] = *(const u32x4*)(qp + 512 + kk * 32); }
#pragma unroll
            for (int i = 0; i < 4; ++i) vraw[i] = *(const u32x4*)(QKV + (brow + (size_t)(128 * (n + 1) + 4 * kg + i) * dil + c) * QKVW + qcol + 1024 + dg * 8); }
        f32x4 sacc[10];
#pragma unroll
        for (int p = 0; p < 9; ++p) { sacc[p] = (f32x4){0.f, 0.f, 0.f, 0.f}; const int kt = wid + p;
            if (n > 0 || kt >= 8) { const int ktp = kt ^ kx;
#pragma unroll
                for (int kk = 0; kk < 4; ++kk) { const bf16x8 a = *(const LAS bf16x8*)(L + (16 * ktp + fr) * KS_STRIDE + (kk * 32 + fq * 8) * 2);
                    sacc[p] = __builtin_amdgcn_mfma_f32_16x16x32_bf16(a, qf[kk], sacc[p], 0, 0, 0); } } }
        float mx = -INFINITY;
#pragma unroll
        for (int p = 0; p < 9; ++p) { const bool tile_ok = (n > 0) || (wid + p >= 8);
#pragma unroll
            for (int jj = 0; jj < 4; ++jj) { const int e = 4 * fq + jj - fr;
                const bool valid = tile_ok && (p == 0 ? e >= 0 : (p == 8 ? e <= 0 : true));
                sacc[p][jj] = valid ? sacc[p][jj] : -INFINITY; mx = fmaxf(mx, sacc[p][jj]); } }
        mx = fmaxf(mx, __shfl_xor(mx, 16)); mx = fmaxf(mx, __shfl_xor(mx, 32));
        float den = 0.f;
#pragma unroll
        for (int p = 0; p < 9; ++p)
#pragma unroll
            for (int jj = 0; jj < 4; ++jj) { const float e = __builtin_amdgcn_exp2f(sacc[p][jj] - mx); sacc[p][jj] = e; den += e; }
        sacc[9] = (f32x4){0.f, 0.f, 0.f, 0.f};
        den += __shfl_xor(den, 16); den += __shfl_xor(den, 32);
        f32x4 oacc[8];
#pragma unroll
        for (int dt = 0; dt < 8; ++dt) oacc[dt] = (f32x4){0.f, 0.f, 0.f, 0.f};
#pragma unroll
        for (int pp = 0; pp < 5; ++pp) { const int kt0 = wid + 2 * pp, kt1 = (kt0 + 1 < 16) ? kt0 + 1 : 15;
            if (n > 0 || kt0 + 1 >= 8) { const int kp0 = kt0 ^ kx, kp1 = kt1 ^ kx;
                u32x4 pw; pw.x = pk2(sacc[2 * pp][0], sacc[2 * pp][1]); pw.y = pk2(sacc[2 * pp][2], sacc[2 * pp][3]); pw.z = pk2(sacc[2 * pp + 1][0], sacc[2 * pp + 1][1]); pw.w = pk2(sacc[2 * pp + 1][2], sacc[2 * pp + 1][3]);
                const bf16x8 pb = __builtin_bit_cast(bf16x8, pw);
#pragma unroll
                for (int dt = 0; dt < 8; ++dt) { const LAS unsigned char* vrow = L + VT_OFF + (16 * dt + fr) * VT_STRIDE + (4 * fq) * 2;
                    const u32x2 lo = *(const LAS u32x2*)(vrow + kp0 * 32), hi = *(const LAS u32x2*)(vrow + kp1 * 32);
                    u32x4 aw; aw.x = lo.x; aw.y = lo.y; aw.z = hi.x; aw.w = hi.y;
                    oacc[dt] = __builtin_amdgcn_mfma_f32_16x16x32_bf16(__builtin_bit_cast(bf16x8, aw), pb, oacc[dt], 0, 0, 0); } } }
        if (n + 1 == nblk && threadIdx.x == 0) *bc = nxt;
        { const float inv = 1.0f / den; const size_t row = brow + sq;
          bf16_t* OG = (bf16_t*)P.out + ((size_t)g * MROWS + row) * ATTW + h * 128 + 4 * fq;
#pragma unroll
          for (int dt = 0; dt < 8; ++dt) { u32x2 w; w.x = pk2(oacc[dt][0] * inv, oacc[dt][1] * inv); w.y = pk2(oacc[dt][2] * inv, oacc[dt][3] * inv); *(u32x2*)(OG + 16 * dt) = w; }
          if (fq == 0) ((float*)(P.ws + OFF_LSE))[((size_t)g * MROWS + row) * 4 + h] = (mx + __log2f(den)) * 0.6931471805599453f; }
        asm volatile("s_waitcnt lgkmcnt(0)" ::: "memory"); __builtin_amdgcn_s_barrier(); asm volatile("" ::: "memory");
    }
}

constexpr int LXC = 128 * XC_STRIDE;
constexpr int HS_OFF = 2 * LXC, HALO_OFF = 4 * LXC;
__device__ __forceinline__ void lru_seq(const Params& P, LAS unsigned char* L, int it, unsigned* ctr, LAS int* qnext) {
    int nxt = 0;
    int tid = threadIdx.x; asm volatile("" : "+v"(tid));
    const int wid = tid >> 6, lane = tid & 63, fr = lane & 15, fq = lane >> 4;
    const int b = it / 10, n = it % 10;
    bf16_t* XR = (bf16_t*)(P.ws + OFF_XR);
    const int cg8 = tid & 15, tg = tid >> 4, ch0 = 128 * n + 8 * cg8;
    f32x2 wk[4][4], bc[4];
#pragma unroll
    for (int k = 0; k < 4; ++k) { const f32x4 a = *(const f32x4*)(P.conv_w + k * DRNN + ch0), bq = *(const f32x4*)(P.conv_w + k * DRNN + ch0 + 4);
        wk[k][0] = (f32x2){a[0], a[1]}; wk[k][1] = (f32x2){a[2], a[3]}; wk[k][2] = (f32x2){bq[0], bq[1]}; wk[k][3] = (f32x2){bq[2], bq[3]}; }
    { const f32x4 a = *(const f32x4*)(P.conv_b + ch0), bq = *(const f32x4*)(P.conv_b + ch0 + 4);
      bc[0] = (f32x2){a[0], a[1]}; bc[1] = (f32x2){a[2], a[3]}; bc[2] = (f32x2){bq[0], bq[1]}; bc[3] = (f32x2){bq[2], bq[3]}; }
    const int ch = 128 * n + 16 * wid + fr;
    bf16x8 bfa[4], bfx[4];
    { const bf16_t* WA = (const bf16_t*)(P.ws + OFF_WGA) + (size_t)n * 16384 + (16 * wid + fr) * 128 + fq * 8;
      const bf16_t* WX = (const bf16_t*)(P.ws + OFF_WGX) + (size_t)n * 16384 + (16 * wid + fr) * 128 + fq * 8;
#pragma unroll
      for (int kk = 0; kk < 4; ++kk) { bfa[kk] = __builtin_bit_cast(bf16x8, *(const u32x4*)(WA + kk * 32)); bfx[kk] = __builtin_bit_cast(bf16x8, *(const u32x4*)(WX + kk * 32)); } }
    const float LOG2E = 1.4426950408889634f;
    const float ba2 = -P.b_rg_a[ch] * LOG2E, bx2 = -P.b_rg_x[ch] * LOG2E, cs = -8.0f * LOG2E * log1pf(__expf(-P.lam[ch]));
    float hc = 0.f;
    u32x4 xw[7];
    const bf16_t* xrow = XR + ((size_t)b * SEQ + 4 * tg - 3) * DRNN + ch0;
#pragma unroll
    for (int ri = 0; ri < 7; ++ri) xw[ri] = (tg == 0 && ri < 3) ? (u32x4){0u, 0u, 0u, 0u} : *(const u32x4*)(xrow + (size_t)ri * DRNN);
    auto stepA = [&](int ca) {
        if (tg == 0 && ca > 0) {
#pragma unroll
            for (int ri = 0; ri < 3; ++ri) xw[ri] = *(const LAS u32x4*)(L + HALO_OFF + ((ca & 1) ^ 1) * 768 + ri * 256 + cg8 * 16); }
        if (tg == 31) {
#pragma unroll
            for (int ri = 4; ri < 7; ++ri) *(LAS u32x4*)(L + HALO_OFF + (ca & 1) * 768 + (ri - 4) * 256 + cg8 * 16) = xw[ri]; }
        f32x2 xin[7][4];
#pragma unroll
        for (int ri = 0; ri < 7; ++ri)
#pragma unroll
            for (int i = 0; i < 4; ++i) xin[ri][i] = (f32x2){bflo(xw[ri][i]), bfhi(xw[ri][i])};
#pragma unroll
        for (int o = 0; o < 4; ++o) { u32x4 w;
#pragma unroll
            for (int i = 0; i < 4; ++i) { const f32x2 y = wk[3][i] * xin[o + 3][i] + (wk[2][i] * xin[o + 2][i] + (wk[1][i] * xin[o + 1][i] + (wk[0][i] * xin[o][i] + bc[i]))); w[i] = pk2(y.x, y.y); }
            *(LAS u32x4*)(L + (ca & 1) * LXC + (4 * tg + o) * XC_STRIDE + cg8 * 16) = w; }
    };
    stepA(0);
    __syncthreads();
    for (int ck = 0; ck < 16; ++ck) {
        const int t0 = ck * 128;
        LAS unsigned char* Xc = L + (ck & 1) * LXC; LAS unsigned char* Hs = L + HS_OFF + (ck & 1) * LXC;
        if (ck == 15 && threadIdx.x == 0) nxt = (int)atomicAdd(ctr, 1u);
        if (ck < 15) {
#pragma unroll
            for (int ri = 0; ri < 7; ++ri) if (!(tg == 0 && ri < 3)) xw[ri] = *(const u32x4*)(xrow + (size_t)(t0 + 128 + ri) * DRNN); }
#pragma unroll
        for (int m = 0; m < 8; ++m) {
            f32x4 aa = (f32x4){0.f, 0.f, 0.f, 0.f}, ax = (f32x4){0.f, 0.f, 0.f, 0.f};
#pragma unroll
            for (int kk = 0; kk < 4; ++kk) { const bf16x8 a = *(const LAS bf16x8*)(Xc + (16 * m + fr) * XC_STRIDE + (kk * 32 + fq * 8) * 2);
                aa = __builtin_amdgcn_mfma_f32_16x16x32_bf16(a, bfa[kk], aa, 0, 0, 0); ax = __builtin_amdgcn_mfma_f32_16x16x32_bf16(a, bfx[kk], ax, 0, 0, 0); }
            float av[4], uv[4];
#pragma unroll
            for (int jj = 0; jj < 4; ++jj) { const int tl = 16 * m + 4 * fq + jj;
                const float rg = __builtin_amdgcn_rcpf(1.0f + __builtin_amdgcn_exp2f(fmaf(aa[jj], -LOG2E, ba2)));
                const float ig = __builtin_amdgcn_rcpf(1.0f + __builtin_amdgcn_exp2f(fmaf(ax[jj], -LOG2E, bx2)));
                const float a = __builtin_amdgcn_exp2f(cs * rg);
                float mult = __builtin_amdgcn_sqrtf(fmaf(-a, a, 1.0f));
                if (m == 0 && jj == 0) mult = (ck == 0 && fq == 0) ? 1.0f : mult;
                const float xcv = bf2f(*(const LAS bf16_t*)(Xc + tl * XC_STRIDE + (16 * wid + fr) * 2));
                av[jj] = a; uv[jj] = mult * ig * xcv; }
            float AL = av[0], HL = uv[0];
#pragma unroll
            for (int jj = 1; jj < 4; ++jj) { HL = fmaf(av[jj], HL, uv[jj]); AL *= av[jj]; }
            const float A0 = __shfl(AL, fr), H0 = __shfl(HL, fr), A1 = __shfl(AL, fr + 16), H1 = __shfl(HL, fr + 16), A2 = __shfl(AL, fr + 32), H2 = __shfl(HL, fr + 32), A3 = __shfl(AL, fr + 48), H3 = __shfl(HL, fr + 48);
            const float h0 = hc, h1 = fmaf(A0, h0, H0), h2 = fmaf(A1, h1, H1), h3 = fmaf(A2, h2, H2), he = fmaf(A3, h3, H3);
            float hh = fq == 0 ? h0 : (fq == 1 ? h1 : (fq == 2 ? h2 : h3));
#pragma unroll
            for (int jj = 0; jj < 4; ++jj) { hh = fmaf(av[jj], hh, uv[jj]);
                *(LAS bf16_t*)(Hs + (16 * m + 4 * fq + jj) * XC_STRIDE + (16 * wid + fr) * 2) = (bf16_t)(pk2(hh, 0.f) & 0xffffu); }
            hc = he;
        }
        if (ck < 15) stepA(ck + 1);
        if (ck == 15 && threadIdx.x == 0) *qnext = nxt;
        __syncthreads();
#pragma unroll
        for (int o = 0; o < 4; ++o) *(u32x4*)(XR + ((size_t)b * SEQ + t0 + 4 * tg + o) * DRNN + ch0) = *(const LAS u32x4*)(Hs + (4 * tg + o) * XC_STRIDE + cg8 * 16);
    }
    __syncthreads();
}

#define XB_TMO      128
#define XB_XCNT(j)  (256  + 64 * (j))
#define XB_XSUB(j)  (1280 + 64 * (j))
#define XB_XGEN(j)  (2304 + 64 * (j))
#define XB_TOP      3328
#define XB_TOPGEN   3392
#define XCD_BAR_WORDS 3456
#define XB_SPIN_CAP (1u << 18)
__device__ __forceinline__ unsigned xb_ld(unsigned* p)              { return __hip_atomic_load(p, __ATOMIC_RELAXED, __HIP_MEMORY_SCOPE_AGENT); }
__device__ __forceinline__ unsigned xb_add(unsigned* p, unsigned v) { return __hip_atomic_fetch_add(p, v, __ATOMIC_RELAXED, __HIP_MEMORY_SCOPE_AGENT); }
__device__ __forceinline__ unsigned xb_xcc_id() { return (unsigned)__builtin_amdgcn_s_getreg((3 << 11) | 20) & 0xFu; }
#define XB_SPIN(cond, bar) do { unsigned _sp = 0; while (cond) { __builtin_amdgcn_s_sleep(1); \
    if ((++_sp & 255u) == 0u) { if (xb_ld(&(bar)[XB_TMO])) break; if (_sp > XB_SPIN_CAP) { atomicAdd(&(bar)[XB_TMO], 1u); break; } } } } while (0)
struct XcdBarrier { unsigned* bar; unsigned x; volatile LAS unsigned* st; };
__device__ __forceinline__ XcdBarrier xcd_barrier_post(unsigned* bar, volatile LAS unsigned* st) {
    XcdBarrier b; b.bar = bar; b.x = xb_xcc_id(); b.st = st;
    if (threadIdx.x == 0) (void)xb_add(&bar[XB_XCNT(b.x)], 1u);
    return b;
}
__device__ __forceinline__ void xcd_barrier_complete(unsigned* bar, unsigned x, unsigned& nloc, unsigned& nx) {
    const unsigned G = gridDim.x * gridDim.y * gridDim.z;
    unsigned sum, cnt, mine, sp = 0u;
    for (;;) {
        sum = 0u; cnt = 0u; mine = 0u;
#pragma unroll
        for (unsigned j = 0; j < 16; ++j) { const unsigned c = xb_ld(&bar[XB_XCNT(j)]); sum += c; cnt += (c > 0u) ? 1u : 0u; mine = (j == x) ? c : mine; }
        if (sum == G) break;
        __builtin_amdgcn_s_sleep(1);
        if ((++sp & 255u) == 0u) { if (xb_ld(&bar[XB_TMO])) break; if (sp > XB_SPIN_CAP) { atomicAdd(&bar[XB_TMO], 1u); break; } }
    }
    nloc = mine > 0u ? mine : 1u; nx = cnt > 0u ? cnt : 1u;
}
__device__ __forceinline__ void xcd_barrier(const XcdBarrier& b) {
    asm volatile("s_waitcnt vmcnt(0)" ::: "memory");
    __syncthreads();
    if (threadIdx.x == 0) {
        unsigned* bar = b.bar;
        __builtin_amdgcn_s_waitcnt(0);
        unsigned nloc = b.st[0], nx = b.st[1];
        if (nloc == 0u) { xcd_barrier_complete(bar, b.x, nloc, nx); b.st[0] = nloc; b.st[1] = nx; }
        const unsigned old = xb_add(&bar[XB_XSUB(b.x)], 1u);
        const unsigned gen = old / nloc;
        if (old + 1u == (gen + 1u) * nloc) {
            __builtin_amdgcn_fence(__ATOMIC_RELEASE, "agent");
            asm volatile("s_waitcnt vmcnt(0)" ::: "memory");
            const unsigned og = xb_add(&bar[XB_TOP], 1u);
            const unsigned tg = og / nx;
            if (og + 1u == (tg + 1u) * nx) xb_add(&bar[XB_TOPGEN], 1u);
            else XB_SPIN(xb_ld(&bar[XB_TOPGEN]) == tg, bar);
            __builtin_amdgcn_fence(__ATOMIC_ACQUIRE, "agent");
            xb_add(&bar[XB_XGEN(b.x)], 1u);
            asm volatile("s_waitcnt vmcnt(0)" ::: "memory");
        } else {
            XB_SPIN(xb_ld(&bar[XB_XGEN(b.x)]) == gen, bar);
            __builtin_amdgcn_fence(__ATOMIC_ACQUIRE, "agent");
            asm volatile("s_waitcnt vmcnt(0)" ::: "memory");
        }
    }
    __syncthreads();
}

#ifndef REPEAT_MASK
#define REPEAT_MASK 0
#endif
#define NREP(bit) (((REPEAT_MASK >> (bit)) & 1) ? 2 : 1)
__global__ void __launch_bounds__(512, 2) fwd_megakernel(Params P) {
    extern __shared__ __attribute__((aligned(16))) unsigned char shm[];
    LAS unsigned char* L = (LAS unsigned char*)shm;
    cg::grid_group grid = cg::this_grid();
    unsigned char* ws = P.ws;
    const int G = (int)gridDim.x, c = (int)blockIdx.x;
    pg8::StaticOrder S;
    volatile LAS unsigned* xst = (volatile LAS unsigned*)(L + LDS_BYTES - 8);
    if (threadIdx.x == 0) { xst[0] = 0u; xst[1] = 0u; }
    __syncthreads();
    if (ws == nullptr) grid.sync();
    const XcdBarrier xb = xcd_barrier_post((unsigned*)(ws + OFF_BAR), xst);
    for (int rep = 0; rep < NREP(0); ++rep) phase0(P, L);
    xcd_barrier(xb);
    for (int rep = 0; rep < NREP(1); ++rep)
    { pg8::Gemm g{(const bf16_t*)(ws + OFF_HN), (const bf16_t*)(ws + OFF_WIN), MROWS, NA, DM}; S.init(MROWS, NA, G, c);
      EpiProj<0> E{(const float*)(ws + OFF_BIN), ws, nullptr};
      pg8::gemm_phase(L, g, S, E); }
    xcd_barrier(xb);
    {
        unsigned* ctr = (unsigned*)(ws + OFF_CTR);
        LAS int* bc = (LAS int*)(L + LDS_BYTES - 16);
        { LAS float* gl = (LAS float*)(L + GAIN_OFF);
          for (int i = threadIdx.x; i < 768; i += 512) { const int gq = i >> 8, j = i & 255; gl[i] = j < 128 ? P.k_norm[gq * 128 + j] : P.q_norm[gq * 128 + j - 128]; } }
        if (threadIdx.x == 0) *bc = (int)atomicAdd(ctr, 1u);
        __syncthreads();
        for (;;) {
            const int it = *bc;
            if (it >= 160 + 1344) break;
            if (it < 64) attn_seq(P, L, it, ctr, bc); else if (it < 224) lru_seq(P, L, it - 64, ctr, bc); else attn_seq(P, L, it - 160, ctr, bc);
        }
        __syncthreads();
    }
    xcd_barrier(xb);
    for (int rep = 0; rep < NREP(3); ++rep)
    { pg8::Gemm g{(const bf16_t*)(ws + OFF_HN), (const bf16_t*)(ws + OFF_WIN) + (size_t)NA * DM, MROWS, NB, DM}; S.init(MROWS, NB, G, c);
      EpiProj<1> E{(const float*)(ws + OFF_BIN) + NA, ws, (const void*)P.out};
      pg8::gemm_phase(L, g, S, E); }
    xcd_barrier(xb);
    for (int rep = 0; rep < NREP(4); ++rep)
    { pg8::Gemm g{(const bf16_t*)(ws + OFF_ZR), (const bf16_t*)(ws + OFF_WR), MROWS, DM, 1792}; S.init(MROWS, DM, G, c);
      EpiMergeFused E{(const bf16_t*)(ws + OFF_G), (bf16_t*)(ws + OFF_HN), (const bf16_t*)(ws + OFF_GX)};
      pg8::gemm_phase(L, g, S, E); }
    xcd_barrier(xb);
    for (int rep = 0; rep < NREP(5); ++rep)
    { pg8::Gemm g{(const bf16_t*)(ws + OFF_HN), (const bf16_t*)(ws + OFF_WOUT), MROWS, DM, DM}; S.init(MROWS, DM, G, c);
      EpiX1 E{P.x, P.out, (bf16_t*)(ws + OFF_XR), (float*)(ws + OFF_SSQ)};
      pg8::gemm_phase(L, g, S, E); }
    xcd_barrier(xb);
    for (int rep = 0; rep < NREP(6); ++rep) {
    { pg8::Gemm g{(const bf16_t*)(ws + OFF_PB), (const bf16_t*)(ws + OFF_WPE), MROWS, DM, PLE}; S.init(MROWS, DM, G, c);
      EpiPe E{(bf16_t*)(ws + OFF_G), (const float*)(ws + OFF_SSQ), (float*)(ws + OFF_TOT)};
      pg8::gemm_phase(L, g, S, E); }
    { pg8::Gemm g{(const bf16_t*)(ws + OFF_XR), (const bf16_t*)(ws + OFF_WPG), MROWS, DM, DM}; S.init(MROWS, DM, G, c);
      EpiFinal E{(const bf16_t*)(ws + OFF_G), (const float*)(ws + OFF_TOT), P.b_ple_gate, P.out, (const bf16_t*)(ws + OFF_XR)};
      pg8::gemm_phase(L, g, S, E); } }
}

extern "C" void kernel_launch(void* const* d_in, const int* in_sizes, int n_in, void* d_out, int out_size, void* d_ws, size_t ws_size, hipStream_t stream) {
    static int grid_blocks = 0;
    if (grid_blocks == 0) {
        if (n_in != 21 || in_sizes[0] != MROWS * DM || out_size != MROWS * DM || ws_size < WS_END) { fprintf(stderr, "kernel_launch: unexpected shapes / workspace (n_in %d, ws %zu, need %zu)\n", n_in, ws_size, (size_t)WS_END); grid_blocks = -1; return; }
        int dev = 0, cus = 0, per_cu = 0;
        (void)hipGetDevice(&dev);
        (void)hipDeviceGetAttribute(&cus, hipDeviceAttributeMultiprocessorCount, dev);
        if (hipFuncSetAttribute((const void*)fwd_megakernel, hipFuncAttributeMaxDynamicSharedMemorySize, LDS_BYTES) != hipSuccess) { fprintf(stderr, "kernel_launch: hipFuncSetAttribute failed\n"); grid_blocks = -1; return; }
        if (hipOccupancyMaxActiveBlocksPerMultiprocessor(&per_cu, (const void*)fwd_megakernel, 512, LDS_BYTES) != hipSuccess || per_cu < 1) { fprintf(stderr, "kernel_launch: occupancy query failed (%d)\n", per_cu); per_cu = 1; (void)hipGetLastError(); }
        grid_blocks = cus * 1;
    }
    if (grid_blocks < 0) return;
    Params P{};
    P.x = (const float*)d_in[0]; P.p = (const float*)d_in[1]; P.norm_mix = (const float*)d_in[2]; P.w_in = (const float*)d_in[3]; P.b_in = (const float*)d_in[4];
    P.conv_w = (const float*)d_in[5]; P.conv_b = (const float*)d_in[6]; P.w_rg_a = (const float*)d_in[7]; P.b_rg_a = (const float*)d_in[8]; P.w_rg_x = (const float*)d_in[9]; P.b_rg_x = (const float*)d_in[10];
    P.lam = (const float*)d_in[11]; P.q_norm = (const float*)d_in[12]; P.k_norm = (const float*)d_in[13]; P.w_o_rnn = (const float*)d_in[14]; P.w_o_att = (const float*)d_in[15]; P.w_out = (const float*)d_in[16];
    P.norm_ple = (const float*)d_in[17]; P.w_ple_gate = (const float*)d_in[18]; P.b_ple_gate = (const float*)d_in[19]; P.w_ple = (const float*)d_in[20];
    P.out = (float*)d_out; P.ws = (unsigned char*)d_ws;
    if (hipMemsetAsync((char*)d_ws + OFF_CTR, 0, OFF_HN - OFF_CTR, stream) != hipSuccess) { fprintf(stderr, "kernel_launch: hipMemsetAsync of the barrier / queue words failed\n"); return; }
    void* args[] = {&P};
    hipError_t e = hipLaunchCooperativeKernel((const void*)fwd_megakernel, dim3(grid_blocks), dim3(512), args, LDS_BYTES, stream);
    if (e != hipSuccess) fprintf(stderr, "cooperative launch failed: %s (grid %d)\n", hipGetErrorString(e), grid_blocks);
}
```

```cpp
#include <hip/hip_runtime.h>
#include <hip/hip_cooperative_groups.h>
#include <cstdio>
namespace cg = cooperative_groups;

#define LAS __attribute__((address_space(3)))
typedef unsigned short bf16_t;
typedef short bf16x8 __attribute__((ext_vector_type(8)));
typedef float f32x4 __attribute__((ext_vector_type(4)));
typedef unsigned u32x4 __attribute__((ext_vector_type(4)));
typedef unsigned u32x2 __attribute__((ext_vector_type(2)));

constexpr int MROWS = 32768, SEQ = 2048, DM = 1024, DRNN = 1280, NIN = 9728, PLE = 256, QKVW = 4608, ATTW = 512;
constexpr int NA = 6144;
constexpr int NB = 3584;
constexpr float EPS = 1e-6f;

constexpr size_t al256(size_t x) { return (x + 255) & ~(size_t)255; }
constexpr size_t OFF_WIN = 0;
constexpr size_t OFF_WR = al256(OFF_WIN + (size_t)NIN * DM * 2);
constexpr size_t OFF_WA = al256(OFF_WR + (size_t)DM * DRNN * 2);
constexpr size_t OFF_WOUT = al256(OFF_WA + (size_t)DM * ATTW * 2);
constexpr size_t OFF_WPG = al256(OFF_WOUT + (size_t)DM * DM * 2);
constexpr size_t OFF_WPE = al256(OFF_WPG + (size_t)DM * DM * 2);
constexpr size_t OFF_WGA = al256(OFF_WPE + (size_t)DM * PLE * 2);
constexpr size_t OFF_WGX = al256(OFF_WGA + (size_t)10 * 128 * 128 * 2);
constexpr size_t OFF_BIN = al256(OFF_WGX + (size_t)10 * 128 * 128 * 2);
constexpr size_t OFF_ROPE = al256(OFF_BIN + (size_t)NIN * 4);
constexpr size_t OFF_TOT = al256(OFF_ROPE + (size_t)2 * SEQ * 64 * 4);
constexpr size_t OFF_LSE = al256(OFF_TOT + (size_t)16 * 16 * DRNN * 2 * 4);
constexpr size_t OFF_SSQ = al256(OFF_LSE + (size_t)3 * MROWS * 4 * 4);
constexpr size_t OFF_CTR = al256(OFF_SSQ + (size_t)MROWS * 16 * 4);
constexpr size_t OFF_BAR = al256(OFF_CTR + 256);
constexpr size_t OFF_HN = al256(OFF_BAR + 3456 * 4);
constexpr size_t OFF_PB = al256(OFF_HN + (size_t)MROWS * DM * 2);
constexpr size_t OFF_XR = al256(OFF_PB + (size_t)MROWS * PLE * 2);
constexpr size_t OFF_R = al256(OFF_XR + (size_t)MROWS * DRNN * 2);
constexpr size_t OFF_ZR = OFF_R;
constexpr size_t OFF_ZA = al256(OFF_ZR + (size_t)MROWS * DRNN * 2);
constexpr size_t OFF_G = al256(OFF_ZA + (size_t)MROWS * ATTW * 2);
constexpr size_t OFF_GX = al256(OFF_R + (size_t)MROWS * QKVW * 2);
constexpr size_t WS_END = al256(OFF_GX + (size_t)MROWS * 256 * 2);
static_assert(OFF_G + (size_t)MROWS * 2048 * 2 <= WS_END, "region R too small");
static_assert(WS_END <= (size_t)536870912, "workspace over 512 MiB");

constexpr int GAIN_OFF = 4 * 128 * 272 + 1536;
constexpr int LDS_BYTES = 4 * 128 * 272 + 1536 + 3072 + 16;
constexpr int KS_STRIDE = 272, VT_STRIDE = 528, XC_STRIDE = 272;
constexpr int VT_OFF = 256 * KS_STRIDE;

struct Params {
    const float *x, *p, *norm_mix, *w_in, *b_in, *conv_w, *conv_b, *w_rg_a, *b_rg_a, *w_rg_x, *b_rg_x, *lam, *q_norm, *k_norm, *w_o_rnn, *w_o_att, *w_out, *norm_ple, *w_ple_gate, *b_ple_gate, *w_ple;
    float* out; unsigned char* ws;
};

__device__ __forceinline__ unsigned pk2(float lo, float hi) { unsigned r; asm volatile("v_cvt_pk_bf16_f32 %0, %1, %2" : "=v"(r) : "v"(lo), "v"(hi)); return r; }
__device__ __forceinline__ float bflo(unsigned w) { return __uint_as_float(w << 16); }
__device__ __forceinline__ float bfhi(unsigned w) { return __uint_as_float(w & 0xffff0000u); }
__device__ __forceinline__ float bf2f(bf16_t b) { return __uint_as_float(((unsigned)b) << 16); }
__device__ __forceinline__ float wave_sum(float v) {
#pragma unroll
    for (int o = 1; o < 64; o <<= 1) v += __shfl_xor(v, o);
    return v;
}
__device__ __forceinline__ float sigmoidf_(float v) { return __builtin_amdgcn_rcpf(1.0f + __expf(-v)); }
__device__ __forceinline__ float siluf_(float v) { return v * __builtin_amdgcn_rcpf(1.0f + __expf(-v)); }
#define LDS_WAIT() asm volatile("s_waitcnt lgkmcnt(0)" ::: "memory")

#define XB_TMO      128
#define XB_XCNT(j)  (256  + 64 * (j))
#define XB_XSUB(j)  (1280 + 64 * (j))
#define XB_XGEN(j)  (2304 + 64 * (j))
#define XB_TOP      3328
#define XB_TOPGEN   3392
#define XCD_BAR_WORDS 3456
#define XB_SPIN_CAP (1u << 18)
__device__ __forceinline__ unsigned xb_ld(unsigned* p)              { return __hip_atomic_load(p, __ATOMIC_RELAXED, __HIP_MEMORY_SCOPE_AGENT); }
__device__ __forceinline__ unsigned xb_add(unsigned* p, unsigned v) { return __hip_atomic_fetch_add(p, v, __ATOMIC_RELAXED, __HIP_MEMORY_SCOPE_AGENT); }
__device__ __forceinline__ unsigned xb_xcc_id() { return (unsigned)__builtin_amdgcn_s_getreg((3 << 11) | 20) & 0xFu; }
#define XB_SPIN(cond, bar) do { unsigned _sp = 0; while (cond) { __builtin_amdgcn_s_sleep(1); \
    if ((++_sp & 255u) == 0u) { if (xb_ld(&(bar)[XB_TMO])) break; if (_sp > XB_SPIN_CAP) { atomicAdd(&(bar)[XB_TMO], 1u); break; } } } } while (0)
struct XcdBarrier { unsigned* bar; unsigned x; volatile LAS unsigned* st; };
__device__ __forceinline__ XcdBarrier xcd_barrier_post(unsigned* bar, volatile LAS unsigned* st) {
    XcdBarrier b; b.bar = bar; b.x = xb_xcc_id(); b.st = st;
    if (threadIdx.x == 0) (void)xb_add(&bar[XB_XCNT(b.x)], 1u);
    return b;
}
__device__ __forceinline__ void xcd_barrier_complete(unsigned* bar, unsigned x, unsigned& nloc, unsigned& nx) {
    const unsigned G = gridDim.x * gridDim.y * gridDim.z;
    unsigned sum, cnt, mine, sp = 0u;
    for (;;) {
        sum = 0u; cnt = 0u; mine = 0u;
#pragma unroll
        for (unsigned j = 0; j < 16; ++j) { const unsigned c = xb_ld(&bar[XB_XCNT(j)]); sum += c; cnt += (c > 0u) ? 1u : 0u; mine = (j == x) ? c : mine; }
        if (sum == G) break;
        __builtin_amdgcn_s_sleep(1);
        if ((++sp & 255u) == 0u) { if (xb_ld(&bar[XB_TMO])) break; if (sp > XB_SPIN_CAP) { atomicAdd(&bar[XB_TMO], 1u); break; } }
    }
    nloc = mine > 0u ? mine : 1u; nx = cnt > 0u ? cnt : 1u;
}
__device__ __forceinline__ void xcd_barrier(const XcdBarrier& b) {
    asm volatile("s_waitcnt vmcnt(0)" ::: "memory");
    __syncthreads();
    if (threadIdx.x == 0) {
        unsigned* bar = b.bar;
        __builtin_amdgcn_s_waitcnt(0);
        unsigned nloc = b.st[0], nx = b.st[1];
        if (nloc == 0u) { xcd_barrier_complete(bar, b.x, nloc, nx); b.st[0] = nloc; b.st[1] = nx; }
        const unsigned old = xb_add(&bar[XB_XSUB(b.x)], 1u);
        const unsigned gen = old / nloc;
        if (old + 1u == (gen + 1u) * nloc) {
            __builtin_amdgcn_fence(__ATOMIC_RELEASE, "agent");
            asm volatile("s_waitcnt vmcnt(0)" ::: "memory");
            const unsigned og = xb_add(&bar[XB_TOP], 1u);
            const unsigned tg = og / nx;
            if (og + 1u == (tg + 1u) * nx) xb_add(&bar[XB_TOPGEN], 1u);
            else XB_SPIN(xb_ld(&bar[XB_TOPGEN]) == tg, bar);
            __builtin_amdgcn_fence(__ATOMIC_ACQUIRE, "agent");
            xb_add(&bar[XB_XGEN(b.x)], 1u);
            asm volatile("s_waitcnt vmcnt(0)" ::: "memory");
        } else {
            XB_SPIN(xb_ld(&bar[XB_XGEN(b.x)]) == gen, bar);
            __builtin_amdgcn_fence(__ATOMIC_ACQUIRE, "agent");
            asm volatile("s_waitcnt vmcnt(0)" ::: "memory");
        }
    }
    __syncthreads();
}

namespace pg8 {
constexpr int BM = 256, BK = 64, HALF = 128, HTB = HALF * BK * 2, STAGE_BYTES = 8 * HTB, NXCD = 8, WGM = 8;
__host__ __device__ __forceinline__ int lds_byte(int r, int c) { const int st = (r >> 4) * 2 + (c >> 5), rr = r & 15, cc = c & 31, ob = rr * 64 + cc * 2; return st * 1024 + (ob ^ (((ob >> 9) & 1) << 5)); }
__host__ __device__ __forceinline__ void stage_rc(int b, int& R, int& C) { const int st = b / 1024, sb = b % 1024, swz = sb ^ (((sb >> 9) & 1) << 5); R = (st >> 1) * 16 + swz / 64; C = (st & 1) * 32 + (swz % 64) / 2; }
__host__ __device__ __forceinline__ int perm32(int rho) { const int n = rho >> 4, i = rho & 15; return 8 * (i >> 2) + 4 * n + (i & 3); }
struct Unit { int pm, pn; };
struct Gemm { const bf16_t* A; const bf16_t* Bt; int M, N, K; };
struct StaticOrder {
    int nM, nN, nwg, G, c;
    __device__ void init(int M, int N, int G_, int c_) { nM = M / BM; nN = N / BM; nwg = nM * nN; G = G_; c = c_; }
    __device__ bool next(int i, Unit& u) const {
        const long L = (long)i * G + c; if (L >= nwg) return false;
        int wgid = (int)L; { const int q = nwg / NXCD, r = nwg % NXCD, xcd = wgid % NXCD, off = wgid / NXCD; wgid = (xcd < r ? xcd * (q + 1) : r * (q + 1) + (xcd - r) * q) + off; }
        const int nig = WGM * nN, gid = wgid / nig, fm = gid * WGM, gsz = (nM - fm) < WGM ? (nM - fm) : WGM;
        u.pm = fm + ((wgid % nig) % gsz); u.pn = (wgid % nig) / gsz; return true;
    }
};

template <class Epi>
__device__ __forceinline__ void gemm_phase(LAS unsigned char* lds, const Gemm g, const StaticOrder& S, const Epi& E, const XcdBarrier* pre = nullptr) {
    int tid = threadIdx.x; asm volatile("" : "+v"(tid));
    const int wid = __builtin_amdgcn_readfirstlane(tid >> 6), lane = tid & 63, wr = wid >> 2, wc = wid & 3, fr = lane & 15, fq = lane >> 4;
    int K = g.K; asm volatile("" : "+s"(K)); const int nt = K / BK;
    unsigned voffA[2], voffB[2];
#pragma unroll
    for (int i = 0; i < 2; ++i) { int R, C; stage_rc(tid * 16 + i * 8192, R, C); const int Rb = Epi::PERM ? ((R & ~31) + perm32(R & 31)) : R;
        voffA[i] = (unsigned)(R * K + C) * 2u; voffB[i] = (unsigned)(Rb * K + C) * 2u; }
    const size_t kstep = (size_t)(BK * 2);
    const size_t hstep = (size_t)HALF * K * 2;
    const size_t tstep = 2 * hstep;
    const unsigned ldsw = (unsigned)wid * 1024u;
    const int aoff = lds_byte(wr * 64 + fr, fq * 8), boff = lds_byte(wc * 32 + fr, fq * 8);
#define PG8_SA(b, h) (((b) * 2 + (h)) * HTB)
#define PG8_SB(b, h) ((4 + (b) * 2 + (h)) * HTB)
#define PG8_STAGE(bufoff, gbase, voff) do { _Pragma("unroll") for (int _i = 0; _i < 2; ++_i) \
        __builtin_amdgcn_global_load_lds((const unsigned*)((const char*)(gbase) + (voff)[_i]), (LAS unsigned*)(lds + (bufoff) + ldsw + _i * 8192), 16, 0, 0); } while (0)
#define PG8_LDA(dst, b, h) do { _Pragma("unroll") for (int m = 0; m < 4; ++m) _Pragma("unroll") for (int k = 0; k < 2; ++k) dst[m][k] = *(const LAS bf16x8*)(lds + PG8_SA(b, h) + aoff + m * 2048 + k * 1024); } while (0)
#define PG8_LDB(dst, b, h) do { _Pragma("unroll") for (int n = 0; n < 2; ++n) _Pragma("unroll") for (int k = 0; k < 2; ++k) dst[n][k] = *(const LAS bf16x8*)(lds + PG8_SB(b, h) + boff + n * 2048 + k * 1024); } while (0)
#define PG8_MMA(ai, bj, At, Bt) do { __builtin_amdgcn_s_setprio(1); _Pragma("unroll") for (int m = 0; m < 4; ++m) _Pragma("unroll") for (int n = 0; n < 2; ++n) _Pragma("unroll") for (int k = 0; k < 2; ++k) \
        acc[ai][bj][m][n] = __builtin_amdgcn_mfma_f32_16x16x32_bf16(Bt[n][k], At[m][k], acc[ai][bj][m][n], 0, 0, 0); __builtin_amdgcn_s_setprio(0); } while (0)
#define PG8_WAIT_V(n) asm volatile("s_waitcnt vmcnt(" #n ")" ::: "memory")
#define PG8_WAIT_L(n) asm volatile("s_waitcnt lgkmcnt(" #n ")" ::: "memory")
#define PG8_BAR __builtin_amdgcn_s_barrier()
#define PG8_SCHED __builtin_amdgcn_sched_barrier(0)
    Unit cur, nxt; int ui = 0;
    if (!S.next(0, cur)) { if (pre) xcd_barrier(*pre); return; }
    f32x4 acc[2][2][4][2];
#pragma unroll
    for (int a = 0; a < 2; ++a)
#pragma unroll
        for (int b = 0; b < 2; ++b)
#pragma unroll
            for (int m = 0; m < 4; ++m)
#pragma unroll
                for (int n = 0; n < 2; ++n) acc[a][b][m][n] = (f32x4){0.f, 0.f, 0.f, 0.f};
    bf16x8 At[4][2], B0[2][2], B1[2][2];
    f32x4 bvp[2][2];
#pragma unroll
    for (int bj = 0; bj < 2; ++bj)
#pragma unroll
        for (int n = 0; n < 2; ++n) bvp[bj][n] = (f32x4){0.f, 0.f, 0.f, 0.f};
    const char* cA = (const char*)g.A + (size_t)cur.pm * tstep; const char* cB = (const char*)g.Bt + (size_t)cur.pn * tstep;
    if (pre) {
        __syncthreads();
        PG8_STAGE(PG8_SB(0, 0), cB, voffB); PG8_STAGE(PG8_SB(0, 1), cB + hstep, voffB);
        xcd_barrier(*pre);
        PG8_STAGE(PG8_SA(0, 0), cA, voffA); PG8_STAGE(PG8_SA(0, 1), cA + hstep, voffA);
        if (wr == 1) PG8_BAR;
        PG8_WAIT_V(2); PG8_BAR;
    } else {
        PG8_STAGE(PG8_SB(0, 0), cB, voffB); PG8_STAGE(PG8_SA(0, 0), cA, voffA); PG8_STAGE(PG8_SB(0, 1), cB + hstep, voffB); PG8_STAGE(PG8_SA(0, 1), cA + hstep, voffA);
        if (wr == 1) PG8_BAR;
        PG8_WAIT_V(4); PG8_BAR;
    }
    PG8_STAGE(PG8_SB(1, 0), cB + kstep, voffB); PG8_STAGE(PG8_SA(1, 0), cA + kstep, voffA); PG8_STAGE(PG8_SB(1, 1), cB + hstep + kstep, voffB);
    PG8_WAIT_V(6); PG8_BAR;
    for (;;) {
        const bool has_next = S.next(ui + 1, nxt);
        const char* nA = has_next ? (const char*)g.A + (size_t)nxt.pm * tstep : cA; const char* nB = has_next ? (const char*)g.Bt + (size_t)nxt.pn * tstep : cB;
        for (int t = 0; t < nt; t += 2) {
            if constexpr (Epi::MID_T > 0) { if (t == Epi::MID_T) E.mid(acc, cur, wr, wc, fr, fq); }
            const bool last = (t == nt - 2);
            if constexpr (Epi::HAS_BIAS) { if (last) { const float* bp = E.bias + cur.pn * 256 + wc * 32 + 8 * fq;
#pragma unroll
                for (int bj = 0; bj < 2; ++bj)
#pragma unroll
                    for (int n = 0; n < 2; ++n) bvp[bj][n] = *(const f32x4*)(bp + bj * 128 + 4 * n); } }
            const char* a1 = cA + (size_t)(t + 1) * kstep;
            const char* a2 = last ? nA : cA + (size_t)(t + 2) * kstep; const char* b2 = last ? nB : cB + (size_t)(t + 2) * kstep;
            const char* a3 = a2 + kstep; const char* b3 = b2 + kstep;
            PG8_LDB(B0, 0, 0); PG8_SCHED; PG8_LDA(At, 0, 0); PG8_STAGE(PG8_SA(1, 1), a1 + hstep, voffA);
            PG8_WAIT_L(8); PG8_BAR; PG8_WAIT_L(0); PG8_MMA(0, 0, At, B0); PG8_BAR; PG8_SCHED;
            PG8_LDB(B1, 0, 1); PG8_STAGE(PG8_SB(0, 0), b2, voffB);
            PG8_BAR; PG8_WAIT_L(0); PG8_MMA(0, 1, At, B1); PG8_BAR;
            PG8_LDA(At, 0, 1); PG8_STAGE(PG8_SA(0, 0), a2, voffA);
            PG8_BAR; PG8_WAIT_L(0); PG8_MMA(1, 0, At, B0); PG8_BAR; PG8_SCHED;
            PG8_STAGE(PG8_SB(0, 1), b2 + hstep, voffB);
            PG8_WAIT_V(6); PG8_BAR; PG8_MMA(1, 1, At, B1); PG8_BAR;
            PG8_LDB(B0, 1, 0); PG8_SCHED; PG8_LDA(At, 1, 0); PG8_STAGE(PG8_SA(0, 1), a2 + hstep, voffA);
            PG8_WAIT_L(8); PG8_BAR; PG8_WAIT_L(0); PG8_MMA(0, 0, At, B0); PG8_BAR; PG8_SCHED;
            PG8_LDB(B1, 1, 1); PG8_STAGE(PG8_SB(1, 0), b3, voffB);
            PG8_BAR; PG8_WAIT_L(0); PG8_MMA(0, 1, At, B1); PG8_BAR;
            PG8_LDA(At, 1, 1); PG8_STAGE(PG8_SA(1, 0), a3, voffA);
            PG8_BAR; PG8_WAIT_L(0); PG8_MMA(1, 0, At, B0); PG8_BAR; PG8_SCHED;
            PG8_STAGE(PG8_SB(1, 1), b3 + hstep, voffB);
            PG8_WAIT_V(6); PG8_BAR; PG8_MMA(1, 1, At, B1); PG8_BAR;
        }
        if constexpr (Epi::HAS_BIAS) E(acc, cur, wr, wc, fr, fq, bvp); else E(acc, cur, wr, wc, fr, fq);
        if (!has_next) break;
#pragma unroll
        for (int a = 0; a < 2; ++a)
#pragma unroll
            for (int b = 0; b < 2; ++b)
#pragma unroll
                for (int m = 0; m < 4; ++m)
#pragma unroll
                    for (int n = 0; n < 2; ++n) acc[a][b][m][n] = (f32x4){0.f, 0.f, 0.f, 0.f};
        cur = nxt; cA = nA; cB = nB; ++ui;
    }
    PG8_WAIT_V(0);
    if (wr == 0) PG8_BAR;
    PG8_BAR;
#undef PG8_SA
#undef PG8_SB
#undef PG8_STAGE
#undef PG8_LDA
#undef PG8_LDB
#undef PG8_MMA
#undef PG8_WAIT_V
#undef PG8_WAIT_L
#undef PG8_BAR
#undef PG8_SCHED
}
}
using pg8::Unit;

template <int WHICH> struct EpiProj {
    static constexpr bool PERM = true; static constexpr int MID_T = 0; static constexpr bool HAS_BIAS = true;
    const float* bias;
    unsigned char* ws; const void* ogp;
    __device__ __forceinline__ void operator()(const f32x4 (&acc)[2][2][4][2], const Unit& u, int wr, int wc, int fr, int fq, const f32x4 (&bv)[2][2]) const {
        constexpr int pnb0 = 5, pnb1 = WHICH == 0 ? 23 : 7;
        const int t = u.pn < pnb0 ? 0 : (u.pn < pnb1 ? 1 : 2);
        const size_t off = WHICH == 0 ? (t == 0 ? OFF_XR : (t == 1 ? OFF_R : OFF_GX)) : (t == 2 ? OFF_G : OFF_ZR);
        const int ld = WHICH == 0 ? (t == 0 ? DRNN : (t == 1 ? QKVW : 256)) : (t == 2 ? 2048 : 1792);
        const int cbase = WHICH == 1 ? (t == 1 ? DRNN : (t == 2 ? 256 : 0)) : 0;
        bf16_t* base = (bf16_t*)(ws + off);
        const int colt = (u.pn - (t == 0 ? 0 : (t == 1 ? pnb0 : pnb1))) * 256;
        const int row0 = u.pm * 256 + wr * 64 + fr, col0 = colt + wc * 32 + 8 * fq, bcol0 = u.pn * 256 + wc * 32 + 8 * fq;
        const bool sig = (WHICH == 0 && t == 2) || (WHICH == 1 && t == 2);
        if (WHICH == 1 && t == 0) {
#pragma unroll
            for (int ai = 0; ai < 2; ++ai) {
                u32x4 hh[4][2];
#pragma unroll
                for (int m = 0; m < 4; ++m)
#pragma unroll
                    for (int bj = 0; bj < 2; ++bj) hh[m][bj] = *(const u32x4*)((const bf16_t*)(ws + OFF_XR) + (size_t)(row0 + ai * 128 + m * 16) * DRNN + col0 + bj * 128);
#pragma unroll
                for (int m = 0; m < 4; ++m) { bf16_t* rowp = base + (size_t)(row0 + ai * 128 + m * 16) * ld + col0 + cbase;
#pragma unroll
                    for (int bj = 0; bj < 2; ++bj) { const f32x4 v0 = acc[ai][bj][m][0] + bv[bj][0], v1 = acc[ai][bj][m][1] + bv[bj][1]; const u32x4 q = hh[m][bj];
                        u32x4 w; w.x = pk2(siluf_(v0[0]) * bflo(q.x), siluf_(v0[1]) * bfhi(q.x)); w.y = pk2(siluf_(v0[2]) * bflo(q.y), siluf_(v0[3]) * bfhi(q.y));
                        w.z = pk2(siluf_(v1[0]) * bflo(q.z), siluf_(v1[1]) * bfhi(q.z)); w.w = pk2(siluf_(v1[2]) * bflo(q.w), siluf_(v1[3]) * bfhi(q.w));
                        *(u32x4*)(rowp + bj * 128) = w; } }
                asm volatile("" ::: "memory"); }
            return; }
#pragma unroll
        for (int ai = 0; ai < 2; ++ai)
#pragma unroll
        for (int mh = 0; mh < 2; ++mh) {
            f32x4 mul[2][2][2];
            if (WHICH == 1 && t == 1) {
                const float* LSE = (const float*)(ws + OFF_LSE); const bf16_t* OG = (const bf16_t*)ogp;
                u32x4 og[2][2][3]; float ls[2][2][3];
#pragma unroll
                for (int mm = 0; mm < 2; ++mm)
#pragma unroll
                    for (int bj = 0; bj < 2; ++bj) { const size_t row = (size_t)(row0 + ai * 128 + (2 * mh + mm) * 16); const int col = col0 + bj * 128, hd = col >> 7;
#pragma unroll
                        for (int gq = 0; gq < 3; ++gq) { og[mm][bj][gq] = *(const u32x4*)(OG + ((size_t)gq * MROWS + row) * ATTW + col); ls[mm][bj][gq] = LSE[((size_t)gq * MROWS + row) * 4 + hd]; } }
#pragma unroll
                for (int mm = 0; mm < 2; ++mm)
#pragma unroll
                    for (int bj = 0; bj < 2; ++bj) { const float l0 = ls[mm][bj][0], l1 = ls[mm][bj][1], l2 = ls[mm][bj][2];
                        const float mxl = fmaxf(l0, fmaxf(l1, l2)); float w0 = __expf(l0 - mxl), w1 = __expf(l1 - mxl), w2 = __expf(l2 - mxl); const float inv = __builtin_amdgcn_rcpf(w0 + w1 + w2); w0 *= inv; w1 *= inv; w2 *= inv;
                        const u32x4 o0 = og[mm][bj][0], o1 = og[mm][bj][1], o2 = og[mm][bj][2];
                        mul[mm][bj][0] = (f32x4){w0 * bflo(o0.x) + w1 * bflo(o1.x) + w2 * bflo(o2.x), w0 * bfhi(o0.x) + w1 * bfhi(o1.x) + w2 * bfhi(o2.x), w0 * bflo(o0.y) + w1 * bflo(o1.y) + w2 * bflo(o2.y), w0 * bfhi(o0.y) + w1 * bfhi(o1.y) + w2 * bfhi(o2.y)};
                        mul[mm][bj][1] = (f32x4){w0 * bflo(o0.z) + w1 * bflo(o1.z) + w2 * bflo(o2.z), w0 * bfhi(o0.z) + w1 * bfhi(o1.z) + w2 * bfhi(o2.z), w0 * bflo(o0.w) + w1 * bflo(o1.w) + w2 * bflo(o2.w), w0 * bfhi(o0.w) + w1 * bfhi(o1.w) + w2 * bfhi(o2.w)}; } }
            if (sig) {
                const int gj = WHICH == 0 ? 0 : u.pn - 6;
                bf16_t* Rb = WHICH == 0 ? (bf16_t*)(ws + OFF_GX) : (bf16_t*)(ws + OFF_G); const int ldg = WHICH == 0 ? 128 : 1024;
                bf16_t* Gb = Rb + (size_t)MROWS * ldg; const int gcol = (WHICH == 0 ? 0 : gj * 128) + wc * 32 + 8 * fq;
#pragma unroll
                for (int mm = 0; mm < 2; ++mm) { const int m = 2 * mh + mm; const size_t row = (size_t)(row0 + ai * 128 + m * 16);
                    u32x4 wr_, wg_; float rr[8], gg[8];
#pragma unroll
                    for (int n = 0; n < 2; ++n)
#pragma unroll
                        for (int j = 0; j < 4; ++j) { const float a0 = acc[ai][0][m][n][j] + bv[0][n][j], a1 = acc[ai][1][m][n][j] + bv[1][n][j];
                            const float d0 = 1.0f + __expf(-a0), d1 = 1.0f + __expf(-a1);
                            gg[4 * n + j] = __builtin_amdgcn_rcpf(d1); rr[4 * n + j] = d1 * __builtin_amdgcn_rcpf(d0); }
                    wr_.x = pk2(rr[0], rr[1]); wr_.y = pk2(rr[2], rr[3]); wr_.z = pk2(rr[4], rr[5]); wr_.w = pk2(rr[6], rr[7]);
                    wg_.x = pk2(gg[0], gg[1]); wg_.y = pk2(gg[2], gg[3]); wg_.z = pk2(gg[4], gg[5]); wg_.w = pk2(gg[6], gg[7]);
                    *(u32x4*)(Rb + row * ldg + gcol) = wr_; *(u32x4*)(Gb + row * ldg + gcol) = wg_; }
                continue; }
#pragma unroll
            for (int mm = 0; mm < 2; ++mm) { const int m = 2 * mh + mm; bf16_t* rowp = base + (size_t)(row0 + ai * 128 + m * 16) * ld + col0 + cbase;
#pragma unroll
                for (int bj = 0; bj < 2; ++bj) { f32x4 v0 = acc[ai][bj][m][0] + bv[bj][0], v1 = acc[ai][bj][m][1] + bv[bj][1];
                    if (WHICH == 1) {
#pragma unroll
                        for (int j = 0; j < 4; ++j) { v0[j] = siluf_(v0[j]) * mul[mm][bj][0][j]; v1[j] = siluf_(v1[j]) * mul[mm][bj][1][j]; } }
                    u32x4 w; w.x = pk2(v0[0], v0[1]); w.y = pk2(v0[2], v0[3]); w.z = pk2(v1[0], v1[1]); w.w = pk2(v1[2], v1[3]);
                    *(u32x4*)(rowp + bj * 128) = w; } }
            if (WHICH == 1) asm volatile("" ::: "memory"); }
    }
};
struct EpiMergeFused {
    static constexpr bool PERM = true; static constexpr int MID_T = 20; static constexpr bool HAS_BIAS = false;
    const bf16_t* G; bf16_t* MG; const bf16_t* GX;
    __device__ __forceinline__ void mid(f32x4 (&acc)[2][2][4][2], const Unit& u, int wr, int wc, int fr, int fq) const {
        int frx = fr, fqx = fq; asm volatile("" : "+v"(frx), "+v"(fqx));
        const int row0 = u.pm * 256 + wr * 64 + frx, col0 = u.pn * 256 + wc * 32 + 8 * fqx;
        u32x4 rq[2][4][2];
#pragma unroll
        for (int ai = 0; ai < 2; ++ai)
#pragma unroll
            for (int m = 0; m < 4; ++m)
#pragma unroll
                for (int bj = 0; bj < 2; ++bj) { const size_t row = (size_t)(row0 + ai * 128 + m * 16); const int col = col0 + bj * 128;
                    rq[ai][m][bj] = *(const u32x4*)((bj == 0 && u.pn == 0) ? GX + row * 128 + col : G + row * 1024 + col); }
#pragma unroll
        for (int ai = 0; ai < 2; ++ai)
#pragma unroll
            for (int m = 0; m < 4; ++m)
#pragma unroll
                for (int bj = 0; bj < 2; ++bj) { const u32x4 a = rq[ai][m][bj];
                    acc[ai][bj][m][0] *= (f32x4){bflo(a.x), bfhi(a.x), bflo(a.y), bfhi(a.y)}; acc[ai][bj][m][1] *= (f32x4){bflo(a.z), bfhi(a.z), bflo(a.w), bfhi(a.w)}; }
        asm volatile("" ::: "memory");
    }
    __device__ __forceinline__ void operator()(const f32x4 (&acc)[2][2][4][2], const Unit& u, int wr, int wc, int fr, int fq) const {
        const int row0 = u.pm * 256 + wr * 64 + fr, col0 = u.pn * 256 + wc * 32 + 8 * fq;
        const bf16_t* G1 = G + (size_t)MROWS * 1024; const bf16_t* GX1 = GX + (size_t)MROWS * 128;
        u32x4 gg[2][4][2];
#pragma unroll
        for (int ai = 0; ai < 2; ++ai)
#pragma unroll
            for (int m = 0; m < 4; ++m)
#pragma unroll
                for (int bj = 0; bj < 2; ++bj) { const size_t row = (size_t)(row0 + ai * 128 + m * 16); const int col = col0 + bj * 128;
                    gg[ai][m][bj] = *(const u32x4*)((bj == 0 && u.pn == 0) ? GX1 + row * 128 + col : G1 + row * 1024 + col); }
#pragma unroll
        for (int ai = 0; ai < 2; ++ai)
#pragma unroll
            for (int m = 0; m < 4; ++m) { const size_t row = (size_t)(row0 + ai * 128 + m * 16);
#pragma unroll
                for (int bj = 0; bj < 2; ++bj) { const int col = col0 + bj * 128; const u32x4 q = gg[ai][m][bj];
                    const f32x4 a0 = acc[ai][bj][m][0], a1 = acc[ai][bj][m][1];
                    u32x4 w; w.x = pk2(a0[0] * bflo(q.x), a0[1] * bfhi(q.x)); w.y = pk2(a0[2] * bflo(q.y), a0[3] * bfhi(q.y));
                    w.z = pk2(a1[0] * bflo(q.z), a1[1] * bfhi(q.z)); w.w = pk2(a1[2] * bflo(q.w), a1[3] * bfhi(q.w));
                    *(u32x4*)(MG + row * 1024 + col) = w; } }
    }
};
struct EpiX1 {
    static constexpr bool PERM = true; static constexpr int MID_T = 0; static constexpr bool HAS_BIAS = false;
    const float* x; float* X1; bf16_t* X1B; float* SSQ;
    __device__ __forceinline__ void operator()(const f32x4 (&acc)[2][2][4][2], const Unit& u, int wr, int wc, int fr, int fq) const {
        const int row0 = u.pm * 256 + wr * 64 + fr, col0 = u.pn * 256 + wc * 32 + 8 * fq;
#pragma unroll
        for (int ai = 0; ai < 2; ++ai) {
            f32x4 xv[4][2][2];
#pragma unroll
            for (int m = 0; m < 4; ++m)
#pragma unroll
                for (int bj = 0; bj < 2; ++bj) { const size_t o = (size_t)(row0 + ai * 128 + m * 16) * 1024 + col0 + bj * 128; xv[m][bj][0] = *(const f32x4*)(x + o); xv[m][bj][1] = *(const f32x4*)(x + o + 4); }
#pragma unroll
            for (int m = 0; m < 4; ++m) { const size_t row = (size_t)(row0 + ai * 128 + m * 16); float ss = 0.f;
#pragma unroll
                for (int bj = 0; bj < 2; ++bj) { const size_t o = row * 1024 + col0 + bj * 128;
                    const f32x4 v0 = xv[m][bj][0] + acc[ai][bj][m][0], v1 = xv[m][bj][1] + acc[ai][bj][m][1];
                    u32x4 w; w.x = pk2(v0[0], v0[1]); w.y = pk2(v0[2], v0[3]); w.z = pk2(v1[0], v1[1]); w.w = pk2(v1[2], v1[3]);
                    *(u32x4*)(X1B + o) = w;
                    ss += (v0[0] * v0[0] + v0[1] * v0[1]) + (v0[2] * v0[2] + v0[3] * v0[3]) + (v1[0] * v1[0] + v1[1] * v1[1]) + (v1[2] * v1[2] + v1[3] * v1[3]); }
                ss += __shfl_xor(ss, 16); ss += __shfl_xor(ss, 32);
                if (fq == 0) SSQ[row * 16 + u.pn * 4 + wc] = ss; }
            asm volatile("" ::: "memory"); }
    }
};
struct EpiPe {
    static constexpr bool PERM = true; static constexpr int MID_T = 0; static constexpr bool HAS_BIAS = false;
    bf16_t* PE; const float* SSQ; float* RSTD;
    __device__ __forceinline__ void operator()(const f32x4 (&acc)[2][2][4][2], const Unit& u, int wr, int wc, int fr, int fq) const {
        const int row0 = u.pm * 256 + wr * 64 + fr, col0 = u.pn * 256 + wc * 32 + 8 * fq;
#pragma unroll
        for (int ai = 0; ai < 2; ++ai) {
            f32x4 sv[4][4];
#pragma unroll
            for (int m = 0; m < 4; ++m)
#pragma unroll
                for (int q = 0; q < 4; ++q) sv[m][q] = *(const f32x4*)(SSQ + (size_t)(row0 + ai * 128 + m * 16) * 16 + 4 * q);
#pragma unroll
            for (int m = 0; m < 4; ++m) { const f32x4 st = (sv[m][0] + sv[m][1]) + (sv[m][2] + sv[m][3]);
                RSTD[row0 + ai * 128 + m * 16] = rsqrtf(((st[0] + st[1]) + (st[2] + st[3])) * (1.0f / 1024.0f) + EPS); } }
#pragma unroll
        for (int ai = 0; ai < 2; ++ai)
#pragma unroll
            for (int m = 0; m < 4; ++m) { const size_t row = (size_t)(row0 + ai * 128 + m * 16);
#pragma unroll
                for (int bj = 0; bj < 2; ++bj) { const size_t o = row * 1024 + col0 + bj * 128; const f32x4 a0 = acc[ai][bj][m][0], a1 = acc[ai][bj][m][1];
                    u32x4 w; w.x = pk2(a0[0], a0[1]); w.y = pk2(a0[2], a0[3]); w.z = pk2(a1[0], a1[1]); w.w = pk2(a1[2], a1[3]);
                    *(u32x4*)(PE + o) = w; } }
    }
};
struct EpiFinal {
    static constexpr bool PERM = true; static constexpr int MID_T = 0; static constexpr bool HAS_BIAS = false;
    const bf16_t* PE; const float* RSTD; const float* bias; float* out; const bf16_t* X1B;
    __device__ __forceinline__ void operator()(const f32x4 (&acc)[2][2][4][2], const Unit& u, int wr, int wc, int fr, int fq) const {
        const int row0 = u.pm * 256 + wr * 64 + fr, col0 = u.pn * 256 + wc * 32 + 8 * fq;
        f32x4 bv[2][2];
#pragma unroll
        for (int bj = 0; bj < 2; ++bj)
#pragma unroll
            for (int n = 0; n < 2; ++n) bv[bj][n] = *(const f32x4*)(bias + col0 + bj * 128 + 4 * n);
#pragma unroll
        for (int ai = 0; ai < 2; ++ai) {
            float rs[4]; u32x4 pw[4][2], xw[4][2];
#pragma unroll
            for (int m = 0; m < 4; ++m) { rs[m] = RSTD[row0 + ai * 128 + m * 16];
#pragma unroll
                for (int bj = 0; bj < 2; ++bj) { const size_t o = (size_t)(row0 + ai * 128 + m * 16) * 1024 + col0 + bj * 128;
                    pw[m][bj] = *(const u32x4*)(PE + o); xw[m][bj] = *(const u32x4*)(X1B + o); } }
#pragma unroll
            for (int m = 0; m < 4; ++m)
#pragma unroll
                for (int bj = 0; bj < 2; ++bj) { const size_t o = (size_t)(row0 + ai * 128 + m * 16) * 1024 + col0 + bj * 128;
                    const f32x4 a0 = acc[ai][bj][m][0] * rs[m] + bv[bj][0], a1 = acc[ai][bj][m][1] * rs[m] + bv[bj][1];
                    const u32x4 p = pw[m][bj], xq = xw[m][bj];
                    f32x4 r0, r1;
                    r0[0] = bflo(xq.x) + sigmoidf_(a0[0]) * bflo(p.x); r0[1] = bfhi(xq.x) + sigmoidf_(a0[1]) * bfhi(p.x); r0[2] = bflo(xq.y) + sigmoidf_(a0[2]) * bflo(p.y); r0[3] = bfhi(xq.y) + sigmoidf_(a0[3]) * bfhi(p.y);
                    r1[0] = bflo(xq.z) + sigmoidf_(a1[0]) * bflo(p.z); r1[1] = bfhi(xq.z) + sigmoidf_(a1[1]) * bfhi(p.z); r1[2] = bflo(xq.w) + sigmoidf_(a1[2]) * bflo(p.w); r1[3] = bfhi(xq.w) + sigmoidf_(a1[3]) * bfhi(p.w);
                    *(f32x4*)(out + o) = r0; *(f32x4*)(out + o + 4) = r1; }
            asm volatile("" ::: "memory"); }
    }
};

__device__ __forceinline__ void transpose_item(const float* W, int N, bf16_t* WT, int ldk, int k0, int n0, int drow0, const float* kscale, LAS float* scr, int lane) {
    float tv[32];
#pragma unroll
    for (int i = 0; i < 32; ++i) { const int kk = 2 * i + (lane >> 5); tv[i] = W[(size_t)(k0 + kk) * N + n0 + (lane & 31)]; }
#pragma unroll
    for (int i = 0; i < 32; ++i) { const int kk = 2 * i + (lane >> 5); float v = tv[i]; if (kscale) v *= kscale[k0 + kk]; scr[kk * 33 + (lane & 31)] = v; }
    LDS_WAIT();
    const int c = lane & 7;
#pragma unroll
    for (int j = 0; j < 4; ++j) { const int n = (lane >> 3) + 8 * j; const LAS float* s = scr + (8 * c) * 33 + n;
        u32x4 o; o.x = pk2(s[0 * 33], s[1 * 33]); o.y = pk2(s[2 * 33], s[3 * 33]); o.z = pk2(s[4 * 33], s[5 * 33]); o.w = pk2(s[6 * 33], s[7 * 33]);
        *(u32x4*)(WT + (size_t)(drow0 + n) * ldk + k0 + 8 * c) = o; }
    LDS_WAIT();
}
__device__ __forceinline__ int perm_col(int n) {
    if (n < 1280) return n;
    if (n < 2560) return n + 4864;
    if (n < 7168) return n - 1280;
    if (n < 7680) return n + 256;
    const int gi = n - 7680, which = gi >> 10, c = gi & 1023, gpos = (c >> 7) * 256 + which * 128 + (c & 127);
    return gpos < 256 ? 5888 + gpos : 7936 + (gpos - 256);
}

__device__ __forceinline__ void phase0(const Params& P, LAS unsigned char* L) {
    int tid = threadIdx.x; asm volatile("" : "+v"(tid));
    const int wid = tid >> 6, lane = tid & 63;
    const int gw = blockIdx.x * 8 + wid, NGW = gridDim.x * 8;
    const size_t gt = (size_t)blockIdx.x * 512 + tid, NGT = (size_t)gridDim.x * 512;
    unsigned char* ws = P.ws;
    { bf16_t* HN = (bf16_t*)(ws + OFF_HN);
      f32x4 gn[4];
#pragma unroll
      for (int j = 0; j < 4; ++j) gn[j] = *((const f32x4*)P.norm_mix + lane + 64 * j);
      for (int row = gw; row < MROWS; row += 4 * NGW) {
          f32x4 v[4][4];
#pragma unroll
          for (int r = 0; r < 4; ++r) { const int rr = row + r * NGW < MROWS ? row + r * NGW : row; const f32x4* xr = (const f32x4*)(P.x + (size_t)rr * DM) + lane;
#pragma unroll
              for (int j = 0; j < 4; ++j) v[r][j] = xr[64 * j]; }
#pragma unroll
          for (int r = 0; r < 4; ++r) { float s = 0.f;
#pragma unroll
              for (int j = 0; j < 4; ++j) s += (v[r][j][0] * v[r][j][0] + v[r][j][1] * v[r][j][1]) + (v[r][j][2] * v[r][j][2] + v[r][j][3] * v[r][j][3]);
              const float rstd = rsqrtf(wave_sum(s) * (1.0f / DM) + EPS);
              if (row + r * NGW < MROWS) { u32x2* o8 = (u32x2*)(HN + (size_t)(row + r * NGW) * DM) + lane;
#pragma unroll
                  for (int j = 0; j < 4; ++j) { u32x2 w; w.x = pk2(v[r][j][0] * rstd * gn[j][0], v[r][j][1] * rstd * gn[j][1]); w.y = pk2(v[r][j][2] * rstd * gn[j][2], v[r][j][3] * rstd * gn[j][3]); o8[64 * j] = w; } } }
      } }
    { bf16_t* PB = (bf16_t*)(ws + OFF_PB); const size_t NI = (size_t)MROWS * PLE / 8;
      for (size_t i = gt; i < NI; i += 4 * NGT) { f32x4 av[4], bw[4];
#pragma unroll
          for (int r = 0; r < 4; ++r) { const size_t ii = i + r * NGT < NI ? i + r * NGT : i; av[r] = *((const f32x4*)P.p + 2 * ii); bw[r] = *((const f32x4*)P.p + 2 * ii + 1); }
#pragma unroll
          for (int r = 0; r < 4; ++r) if (i + r * NGT < NI) { u32x4 w; w.x = pk2(av[r][0], av[r][1]); w.y = pk2(av[r][2], av[r][3]); w.z = pk2(bw[r][0], bw[r][1]); w.w = pk2(bw[r][2], bw[r][3]); *((u32x4*)PB + i + r * NGT) = w; } } }
    { LAS float* scr = (LAS float*)(L + wid * 8448);
      constexpr int I0 = 16 * 304, I1 = 20 * 32, I2 = 8 * 32, I3 = 16 * 32, I4 = 16 * 32, I5 = 4 * 32, I6 = 80, I7 = 80;
      constexpr int NIT = I0 + I1 + I2 + I3 + I4 + I5 + I6 + I7;
      for (int it = gw; it < NIT; it += NGW) {
          int r = it;
          if (r < I0) { const int kb = r / 304, nb = r % 304; transpose_item(P.w_in, NIN, (bf16_t*)(ws + OFF_WIN), DM, 64 * kb, 32 * nb, perm_col(32 * nb), nullptr, scr, lane); continue; } r -= I0;
          if (r < I1) { const int kb = r / 32, nb = r % 32; transpose_item(P.w_o_rnn, DM, (bf16_t*)(ws + OFF_WR), 1792, 64 * kb, 32 * nb, 32 * nb, nullptr, scr, lane); continue; } r -= I1;
          if (r < I2) { const int kb = r / 32, nb = r % 32; transpose_item(P.w_o_att, DM, (bf16_t*)(ws + OFF_WR) + DRNN, 1792, 64 * kb, 32 * nb, 32 * nb, nullptr, scr, lane); continue; } r -= I2;
          if (r < I3) { const int kb = r / 32, nb = r % 32; transpose_item(P.w_out, DM, (bf16_t*)(ws + OFF_WOUT), DM, 64 * kb, 32 * nb, 32 * nb, nullptr, scr, lane); continue; } r -= I3;
          if (r < I4) { const int kb = r / 32, nb = r % 32; transpose_item(P.w_ple_gate, DM, (bf16_t*)(ws + OFF_WPG), DM, 64 * kb, 32 * nb, 32 * nb, P.norm_ple, scr, lane); continue; } r -= I4;
          if (r < I5) { const int kb = r / 32, nb = r % 32; transpose_item(P.w_ple, DM, (bf16_t*)(ws + OFF_WPE), PLE, 64 * kb, 32 * nb, 32 * nb, nullptr, scr, lane); continue; } r -= I5;
          if (r < I6) { const int mt = r / 8, q = r % 8, kb = q / 4, nb = q % 4; transpose_item(P.w_rg_a + (size_t)mt * 16384, 128, (bf16_t*)(ws + OFF_WGA) + (size_t)mt * 16384, 128, 64 * kb, 32 * nb, 32 * nb, nullptr, scr, lane); continue; } r -= I6;
          { const int mt = r / 8, q = r % 8, kb = q / 4, nb = q % 4; transpose_item(P.w_rg_x + (size_t)mt * 16384, 128, (bf16_t*)(ws + OFF_WGX) + (size_t)mt * 16384, 128, 64 * kb, 32 * nb, 32 * nb, nullptr, scr, lane); }
      } }
    { float* BIN = (float*)(ws + OFF_BIN);
      for (size_t i = gt; i < (size_t)NIN; i += NGT) BIN[perm_col((int)i)] = P.b_in[i];
      float* RC = (float*)(ws + OFF_ROPE); float* RS = RC + SEQ * 64;
      for (size_t i = gt; i < (size_t)SEQ * 64; i += NGT) { const int pos = (int)(i >> 6), j = (int)(i & 63);
          const float inv_freq = (float)exp2(-(double)j * (13.287712379549449 / 64.0));
          const float angf = (float)pos * inv_freq; const double ang = (double)angf; const double k = rint(ang * 0.15915494309189535);
          const float rr = (float)(ang - k * 6.283185307179586);
          RC[i] = __cosf(rr); RS[i] = __sinf(rr); } }
}

typedef float f32x2 __attribute__((ext_vector_type(2)));
__device__ __forceinline__ void norm_rope(u32x4 (&raw)[4], const LAS float* gain_fq, const f32x2 (&cs)[2][4], const f32x2 (&sn)[2][4], float scale) {
    f32x2 v[4][4]; f32x2 ss2 = (f32x2){0.f, 0.f};
#pragma unroll
    for (int kk = 0; kk < 4; ++kk)
#pragma unroll
        for (int i = 0; i < 4; ++i) { const unsigned w = raw[kk][i]; v[kk][i] = (f32x2){bflo(w), bfhi(w)}; ss2 = v[kk][i] * v[kk][i] + ss2; }
    float ss = ss2.x + ss2.y;
    ss += __shfl_xor(ss, 16); ss += __shfl_xor(ss, 32);
    const float rstd = rsqrtf(ss * (1.0f / 128.0f) + EPS) * scale;
#pragma unroll
    for (int kk = 0; kk < 4; ++kk) { const f32x4 g0 = *(const LAS f32x4*)(gain_fq + kk * 32), g1 = *(const LAS f32x4*)(gain_fq + kk * 32 + 4);
        v[kk][0] *= (f32x2){g0[0], g0[1]}; v[kk][1] *= (f32x2){g0[2], g0[3]}; v[kk][2] *= (f32x2){g1[0], g1[1]}; v[kk][3] *= (f32x2){g1[2], g1[3]}; }
#pragma unroll
    for (int kk = 0; kk < 2; ++kk)
#pragma unroll
        for (int i = 0; i < 4; ++i) { const f32x2 cc = cs[kk][i] * rstd, sc = sn[kk][i] * rstd; const f32x2 t1 = v[kk][i], t2 = v[kk + 2][i];
            v[kk][i] = t1 * cc - t2 * sc; v[kk + 2][i] = t2 * cc + t1 * sc; }
#pragma unroll
    for (int kk = 0; kk < 4; ++kk)
#pragma unroll
        for (int i = 0; i < 4; ++i) raw[kk][i] = pk2(v[kk][i].x, v[kk][i].y);
}

__device__ __forceinline__ void attn_seq(const Params& P, LAS unsigned char* L, int u) {
    int tid = threadIdx.x; asm volatile("" : "+v"(tid));
    const int wid = tid >> 6, lane = tid & 63, fr = lane & 15, fq = lane >> 4;
    int g, b, h, c, nblk;
    if (u < 64) { g = 0; b = u >> 2; h = u & 3; c = 0; nblk = 16; }
    else if (u < 320) { const int r = u - 64; g = 1; b = r >> 4; h = (r >> 2) & 3; c = r & 3; nblk = 4; }
    else { const int r = u - 320; g = 2; b = r >> 6; h = (r >> 4) & 3; c = r & 15; nblk = 1; }
    const int dil = 1 << (2 * g);
    const bf16_t* QKV = (const bf16_t*)(P.ws + OFF_R);
    const int qcol = g * 1536 + h * 128;
    const size_t brow = (size_t)b * SEQ;
    const LAS float* gl = (const LAS float*)(L + GAIN_OFF) + g * 256;
    const LAS float* kgain = gl + fq * 8; const LAS float* qgain = gl + 128 + fq * 8;
    f32x2 frev[2][4];
#pragma unroll
    for (int kk = 0; kk < 2; ++kk)
#pragma unroll
        for (int i = 0; i < 4; ++i) { const float j0 = (float)(kk * 32 + fq * 8 + 2 * i);
            frev[kk][i] = (f32x2){__builtin_amdgcn_exp2f(-j0 * (13.287712379549449f / 64.0f)) * 0.15915494309189535f, __builtin_amdgcn_exp2f(-(j0 + 1.0f) * (13.287712379549449f / 64.0f)) * 0.15915494309189535f}; }
    const int dg = (lane >> 4) + 4 * (wid & 3), kg = (lane & 15) + 16 * (wid >> 2);
    u32x4 qraw[4], kraw[4], vraw[4];
    { const bf16_t* qp = QKV + (brow + (size_t)(16 * wid + fr) * dil + c) * QKVW + qcol + fq * 8;
#pragma unroll
      for (int kk = 0; kk < 4; ++kk) { qraw[kk] = *(const u32x4*)(qp + kk * 32); kraw[kk] = *(const u32x4*)(qp + 512 + kk * 32); }
#pragma unroll
      for (int i = 0; i < 4; ++i) vraw[i] = *(const u32x4*)(QKV + (brow + (size_t)(4 * kg + i) * dil + c) * QKVW + qcol + 1024 + dg * 8); }
    for (int n = 0; n < nblk; ++n) {
        const int slot = n & 1, kx = slot ? 0 : 8;
        const int sq = (128 * n + 16 * wid + fr) * dil + c;
        f32x2 cs[2][4], sn[2][4];
#pragma unroll
        for (int kk = 0; kk < 2; ++kk)
#pragma unroll
            for (int i = 0; i < 4; ++i) { const f32x2 rv = frev[kk][i] * (float)sq; const float r0 = __builtin_amdgcn_fractf(rv.x), r1 = __builtin_amdgcn_fractf(rv.y);
                cs[kk][i] = (f32x2){__builtin_amdgcn_cosf(r0), __builtin_amdgcn_cosf(r1)}; sn[kk][i] = (f32x2){__builtin_amdgcn_sinf(r0), __builtin_amdgcn_sinf(r1)}; }
        norm_rope(kraw, kgain, cs, sn, 1.0f);
#pragma unroll
        for (int kk = 0; kk < 4; ++kk) *(LAS u32x4*)(L + (slot * 128 + 16 * wid + fr) * KS_STRIDE + (kk * 32 + fq * 8) * 2) = kraw[kk];
#pragma unroll
        for (int d = 0; d < 8; ++d) { u32x2 o;
            o.x = __builtin_amdgcn_perm(vraw[1][d >> 1], vraw[0][d >> 1], (d & 1) ? 0x07060302u : 0x05040100u);
            o.y = __builtin_amdgcn_perm(vraw[3][d >> 1], vraw[2][d >> 1], (d & 1) ? 0x07060302u : 0x05040100u);
            *(LAS u32x2*)(L + VT_OFF + (8 * dg + d) * VT_STRIDE + (slot * 128 + 4 * kg) * 2) = o;
            if (n == 0) *(LAS u32x2*)(L + VT_OFF + (8 * dg + d) * VT_STRIDE + ((slot ^ 1) * 128 + 4 * kg) * 2) = (u32x2){0u, 0u}; }
        norm_rope(qraw, qgain, cs, sn, 0.08838834764831845f * 1.4426950408889634f);
        bf16x8 qf[4];
#pragma unroll
        for (int kk = 0; kk < 4; ++kk) qf[kk] = __builtin_bit_cast(bf16x8, qraw[kk]);
        __syncthreads();
        if (n + 1 < nblk) { const bf16_t* qp = QKV + (brow + (size_t)(128 * (n + 1) + 16 * wid + fr) * dil + c) * QKVW + qcol + fq * 8;
#pragma unroll
            for (int kk = 0; kk < 4; ++kk) { qraw[kk] = *(const u32x4*)(qp + kk * 32); kraw[kk] = *(const u32x4*)(qp + 512 + kk * 32); }
#pragma unroll
            for (int i = 0; i < 4; ++i) vraw[i] = *(const u32x4*)(QKV + (brow + (size_t)(128 * (n + 1) + 4 * kg + i) * dil + c) * QKVW + qcol + 1024 + dg * 8); }
        f32x4 sacc[10];
#pragma unroll
        for (int p = 0; p < 9; ++p) { sacc[p] = (f32x4){0.f, 0.f, 0.f, 0.f}; const int kt = wid + p;
            if (n > 0 || kt >= 8) { const int ktp = kt ^ kx;
#pragma unroll
                for (int kk = 0; kk < 4; ++kk) { const bf16x8 a = *(const LAS bf16x8*)(L + (16 * ktp + fr) * KS_STRIDE + (kk * 32 + fq * 8) * 2);
                    sacc[p] = __builtin_amdgcn_mfma_f32_16x16x32_bf16(a, qf[kk], sacc[p], 0, 0, 0); } } }
        float mx = -INFINITY;
#pragma unroll
        for (int p = 0; p < 9; ++p) { const bool tile_ok = (n > 0) || (wid + p >= 8);
#pragma unroll
            for (int jj = 0; jj < 4; ++jj) { const int e = 4 * fq + jj - fr;
                const bool valid = tile_ok && (p == 0 ? e >= 0 : (p == 8 ? e <= 0 : true));
                sacc[p][jj] = valid ? sacc[p][jj] : -INFINITY; mx = fmaxf(mx, sacc[p][jj]); } }
        mx = fmaxf(mx, __shfl_xor(mx, 16)); mx = fmaxf(mx, __shfl_xor(mx, 32));
        float den = 0.f;
#pragma unroll
        for (int p = 0; p < 9; ++p)
#pragma unroll
            for (int jj = 0; jj < 4; ++jj) { const float e = __builtin_amdgcn_exp2f(sacc[p][jj] - mx); sacc[p][jj] = e; den += e; }
        sacc[9] = (f32x4){0.f, 0.f, 0.f, 0.f};
        den += __shfl_xor(den, 16); den += __shfl_xor(den, 32);
        f32x4 oacc[8];
#pragma unroll
        for (int dt = 0; dt < 8; ++dt) oacc[dt] = (f32x4){0.f, 0.f, 0.f, 0.f};
#pragma unroll
        for (int pp = 0; pp < 5; ++pp) { const int kt0 = wid + 2 * pp, kt1 = (kt0 + 1 < 16) ? kt0 + 1 : 15;
            if (n > 0 || kt0 + 1 >= 8) { const int kp0 = kt0 ^ kx, kp1 = kt1 ^ kx;
                u32x4 pw; pw.x = pk2(sacc[2 * pp][0], sacc[2 * pp][1]); pw.y = pk2(sacc[2 * pp][2], sacc[2 * pp][3]); pw.z = pk2(sacc[2 * pp + 1][0], sacc[2 * pp + 1][1]); pw.w = pk2(sacc[2 * pp + 1][2], sacc[2 * pp + 1][3]);
                const bf16x8 pb = __builtin_bit_cast(bf16x8, pw);
#pragma unroll
                for (int dt = 0; dt < 8; ++dt) { const LAS unsigned char* vrow = L + VT_OFF + (16 * dt + fr) * VT_STRIDE + (4 * fq) * 2;
                    const u32x2 lo = *(const LAS u32x2*)(vrow + kp0 * 32), hi = *(const LAS u32x2*)(vrow + kp1 * 32);
                    u32x4 aw; aw.x = lo.x; aw.y = lo.y; aw.z = hi.x; aw.w = hi.y;
                    oacc[dt] = __builtin_amdgcn_mfma_f32_16x16x32_bf16(__builtin_bit_cast(bf16x8, aw), pb, oacc[dt], 0, 0, 0); } } }
        { const float inv = 1.0f / den; const size_t row = brow + sq;
          bf16_t* OG = (bf16_t*)P.out + ((size_t)g * MROWS + row) * ATTW + h * 128 + 4 * fq;
#pragma unroll
          for (int dt = 0; dt < 8; ++dt) { u32x2 w; w.x = pk2(oacc[dt][0] * inv, oacc[dt][1] * inv); w.y = pk2(oacc[dt][2] * inv, oacc[dt][3] * inv); *(u32x2*)(OG + 16 * dt) = w; }
          if (fq == 0) ((float*)(P.ws + OFF_LSE))[((size_t)g * MROWS + row) * 4 + h] = (mx + __log2f(den)) * 0.6931471805599453f; }
        asm volatile("s_waitcnt lgkmcnt(0)" ::: "memory"); __builtin_amdgcn_s_barrier(); asm volatile("" ::: "memory");
    }
}

constexpr int LXC = 128 * XC_STRIDE;
constexpr int HS_OFF = 2 * LXC, HALO_OFF = 4 * LXC;
__device__ __forceinline__ void lru_seq(const Params& P, LAS unsigned char* L, int it) {
    int tid = threadIdx.x; asm volatile("" : "+v"(tid));
    const int wid = tid >> 6, lane = tid & 63, fr = lane & 15, fq = lane >> 4;
    const int b = it / 10, n = it % 10;
    bf16_t* XR = (bf16_t*)(P.ws + OFF_XR);
    const int cg8 = tid & 15, tg = tid >> 4, ch0 = 128 * n + 8 * cg8;
    f32x2 wk[4][4], bc[4];
#pragma unroll
    for (int k = 0; k < 4; ++k) { const f32x4 a = *(const f32x4*)(P.conv_w + k * DRNN + ch0), bq = *(const f32x4*)(P.conv_w + k * DRNN + ch0 + 4);
        wk[k][0] = (f32x2){a[0], a[1]}; wk[k][1] = (f32x2){a[2], a[3]}; wk[k][2] = (f32x2){bq[0], bq[1]}; wk[k][3] = (f32x2){bq[2], bq[3]}; }
    { const f32x4 a = *(const f32x4*)(P.conv_b + ch0), bq = *(const f32x4*)(P.conv_b + ch0 + 4);
      bc[0] = (f32x2){a[0], a[1]}; bc[1] = (f32x2){a[2], a[3]}; bc[2] = (f32x2){bq[0], bq[1]}; bc[3] = (f32x2){bq[2], bq[3]}; }
    const int ch = 128 * n + 16 * wid + fr;
    bf16x8 bfa[4], bfx[4];
    { const bf16_t* WA = (const bf16_t*)(P.ws + OFF_WGA) + (size_t)n * 16384 + (16 * wid + fr) * 128 + fq * 8;
      const bf16_t* WX = (const bf16_t*)(P.ws + OFF_WGX) + (size_t)n * 16384 + (16 * wid + fr) * 128 + fq * 8;
#pragma unroll
      for (int kk = 0; kk < 4; ++kk) { bfa[kk] = __builtin_bit_cast(bf16x8, *(const u32x4*)(WA + kk * 32)); bfx[kk] = __builtin_bit_cast(bf16x8, *(const u32x4*)(WX + kk * 32)); } }
    const float LOG2E = 1.4426950408889634f;
    const float ba2 = -P.b_rg_a[ch] * LOG2E, bx2 = -P.b_rg_x[ch] * LOG2E, cs = -8.0f * LOG2E * log1pf(__expf(-P.lam[ch]));
    float hc = 0.f;
    u32x4 xw[7];
    const bf16_t* xrow = XR + ((size_t)b * SEQ + 4 * tg - 3) * DRNN + ch0;
#pragma unroll
    for (int ri = 0; ri < 7; ++ri) xw[ri] = (tg == 0 && ri < 3) ? (u32x4){0u, 0u, 0u, 0u} : *(const u32x4*)(xrow + (size_t)ri * DRNN);
    auto stepA = [&](int ca) {
        if (tg == 0 && ca > 0) {
#pragma unroll
            for (int ri = 0; ri < 3; ++ri) xw[ri] = *(const LAS u32x4*)(L + HALO_OFF + ((ca & 1) ^ 1) * 768 + ri * 256 + cg8 * 16); }
        if (tg == 31) {
#pragma unroll
            for (int ri = 4; ri < 7; ++ri) *(LAS u32x4*)(L + HALO_OFF + (ca & 1) * 768 + (ri - 4) * 256 + cg8 * 16) = xw[ri]; }
        f32x2 xin[7][4];
#pragma unroll
        for (int ri = 0; ri < 7; ++ri)
#pragma unroll
            for (int i = 0; i < 4; ++i) xin[ri][i] = (f32x2){bflo(xw[ri][i]), bfhi(xw[ri][i])};
#pragma unroll
        for (int o = 0; o < 4; ++o) { u32x4 w;
#pragma unroll
            for (int i = 0; i < 4; ++i) { const f32x2 y = wk[3][i] * xin[o + 3][i] + (wk[2][i] * xin[o + 2][i] + (wk[1][i] * xin[o + 1][i] + (wk[0][i] * xin[o][i] + bc[i]))); w[i] = pk2(y.x, y.y); }
            *(LAS u32x4*)(L + (ca & 1) * LXC + (4 * tg + o) * XC_STRIDE + cg8 * 16) = w; }
    };
    stepA(0);
    __syncthreads();
    for (int ck = 0; ck < 16; ++ck) {
        const int t0 = ck * 128;
        LAS unsigned char* Xc = L + (ck & 1) * LXC; LAS unsigned char* Hs = L + HS_OFF + (ck & 1) * LXC;
        if (ck < 15) {
#pragma unroll
            for (int ri = 0; ri < 7; ++ri) if (!(tg == 0 && ri < 3)) xw[ri] = *(const u32x4*)(xrow + (size_t)(t0 + 128 + ri) * DRNN); }
#pragma unroll
        for (int m = 0; m < 8; ++m) {
            f32x4 aa = (f32x4){0.f, 0.f, 0.f, 0.f}, ax = (f32x4){0.f, 0.f, 0.f, 0.f};
#pragma unroll
            for (int kk = 0; kk < 4; ++kk) { const bf16x8 a = *(const LAS bf16x8*)(Xc + (16 * m + fr) * XC_STRIDE + (kk * 32 + fq * 8) * 2);
                aa = __builtin_amdgcn_mfma_f32_16x16x32_bf16(a, bfa[kk], aa, 0, 0, 0); ax = __builtin_amdgcn_mfma_f32_16x16x32_bf16(a, bfx[kk], ax, 0, 0, 0); }
            float av[4], uv[4];
#pragma unroll
            for (int jj = 0; jj < 4; ++jj) { const int tl = 16 * m + 4 * fq + jj;
                const float rg = __builtin_amdgcn_rcpf(1.0f + __builtin_amdgcn_exp2f(fmaf(aa[jj], -LOG2E, ba2)));
                const float ig = __builtin_amdgcn_rcpf(1.0f + __builtin_amdgcn_exp2f(fmaf(ax[jj], -LOG2E, bx2)));
                const float a = __builtin_amdgcn_exp2f(cs * rg);
                float mult = __builtin_amdgcn_sqrtf(fmaf(-a, a, 1.0f));
                if (m == 0 && jj == 0) mult = (ck == 0 && fq == 0) ? 1.0f : mult;
                const float xcv = bf2f(*(const LAS bf16_t*)(Xc + tl * XC_STRIDE + (16 * wid + fr) * 2));
                av[jj] = a; uv[jj] = mult * ig * xcv; }
            float AL = av[0], HL = uv[0];
#pragma unroll
            for (int jj = 1; jj < 4; ++jj) { HL = fmaf(av[jj], HL, uv[jj]); AL *= av[jj]; }
            const float A0 = __shfl(AL, fr), H0 = __shfl(HL, fr), A1 = __shfl(AL, fr + 16), H1 = __shfl(HL, fr + 16), A2 = __shfl(AL, fr + 32), H2 = __shfl(HL, fr + 32), A3 = __shfl(AL, fr + 48), H3 = __shfl(HL, fr + 48);
            const float h0 = hc, h1 = fmaf(A0, h0, H0), h2 = fmaf(A1, h1, H1), h3 = fmaf(A2, h2, H2), he = fmaf(A3, h3, H3);
            float hh = fq == 0 ? h0 : (fq == 1 ? h1 : (fq == 2 ? h2 : h3));
#pragma unroll
            for (int jj = 0; jj < 4; ++jj) { hh = fmaf(av[jj], hh, uv[jj]);
                *(LAS bf16_t*)(Hs + (16 * m + 4 * fq + jj) * XC_STRIDE + (16 * wid + fr) * 2) = (bf16_t)(pk2(hh, 0.f) & 0xffffu); }
            hc = he;
        }
        if (ck < 15) stepA(ck + 1);
        __syncthreads();
#pragma unroll
        for (int o = 0; o < 4; ++o) *(u32x4*)(XR + ((size_t)b * SEQ + t0 + 4 * tg + o) * DRNN + ch0) = *(const LAS u32x4*)(Hs + (4 * tg + o) * XC_STRIDE + cg8 * 16);
    }
    __syncthreads();
}

#ifndef REPEAT_MASK
#define REPEAT_MASK 0
#endif
#define NREP(bit) (((REPEAT_MASK >> (bit)) & 1) ? 2 : 1)
__global__ void __launch_bounds__(512, 2) fwd_megakernel(Params P) {
    extern __shared__ __attribute__((aligned(16))) unsigned char shm[];
    LAS unsigned char* L = (LAS unsigned char*)shm;
    cg::grid_group grid = cg::this_grid();
    unsigned char* ws = P.ws;
    const int G = (int)gridDim.x, c = (int)blockIdx.x;
    pg8::StaticOrder S;
    volatile LAS unsigned* xst = (volatile LAS unsigned*)(L + LDS_BYTES - 8);
    if (threadIdx.x == 0) { xst[0] = 0u; xst[1] = 0u; }
    __syncthreads();
    if (ws == nullptr) grid.sync();
    const XcdBarrier xb = xcd_barrier_post((unsigned*)(ws + OFF_BAR), xst);
    for (int rep = 0; rep < NREP(0); ++rep) phase0(P, L);
    xcd_barrier(xb);
    for (int rep = 0; rep < NREP(1); ++rep)
    { pg8::Gemm g{(const bf16_t*)(ws + OFF_HN), (const bf16_t*)(ws + OFF_WIN), MROWS, NA, DM}; S.init(MROWS, NA, G, c);
      EpiProj<0> E{(const float*)(ws + OFF_BIN), ws, nullptr};
      pg8::gemm_phase(L, g, S, E); }
    xcd_barrier(xb);
    {
        unsigned* ctr = (unsigned*)(ws + OFF_CTR);
        LAS int* bc = (LAS int*)(L + LDS_BYTES - 16);
        { LAS float* gl = (LAS float*)(L + GAIN_OFF);
          for (int i = threadIdx.x; i < 768; i += 512) { const int gq = i >> 8, j = i & 255; gl[i] = j < 128 ? P.k_norm[gq * 128 + j] : P.q_norm[gq * 128 + j - 128]; } }
        for (;;) {
            if (threadIdx.x == 0) *bc = (int)atomicAdd(ctr, 1u);
            __syncthreads();
            const int it = *bc;
            if (it >= 160 + 1344) break;
            if (it < 64) attn_seq(P, L, it); else if (it < 224) lru_seq(P, L, it - 64); else attn_seq(P, L, it - 160);
        }
        __syncthreads();
    }
    for (int rep = 0; rep < NREP(3); ++rep)
    { pg8::Gemm g{(const bf16_t*)(ws + OFF_HN), (const bf16_t*)(ws + OFF_WIN) + (size_t)NA * DM, MROWS, NB, DM}; S.init(MROWS, NB, G, c);
      EpiProj<1> E{(const float*)(ws + OFF_BIN) + NA, ws, (const void*)P.out};
      pg8::gemm_phase(L, g, S, E, rep == 0 ? &xb : nullptr); }
    for (int rep = 0; rep < NREP(4); ++rep)
    { pg8::Gemm g{(const bf16_t*)(ws + OFF_ZR), (const bf16_t*)(ws + OFF_WR), MROWS, DM, 1792}; S.init(MROWS, DM, G, c);
      EpiMergeFused E{(const bf16_t*)(ws + OFF_G), (bf16_t*)(ws + OFF_HN), (const bf16_t*)(ws + OFF_GX)};
      pg8::gemm_phase(L, g, S, E, rep == 0 ? &xb : nullptr); }
    for (int rep = 0; rep < NREP(5); ++rep)
    { pg8::Gemm g{(const bf16_t*)(ws + OFF_HN), (const bf16_t*)(ws + OFF_WOUT), MROWS, DM, DM}; S.init(MROWS, DM, G, c);
      EpiX1 E{P.x, P.out, (bf16_t*)(ws + OFF_XR), (float*)(ws + OFF_SSQ)};
      pg8::gemm_phase(L, g, S, E, rep == 0 ? &xb : nullptr); }
    for (int rep = 0; rep < NREP(6); ++rep) {
    { pg8::Gemm g{(const bf16_t*)(ws + OFF_PB), (const bf16_t*)(ws + OFF_WPE), MROWS, DM, PLE}; S.init(MROWS, DM, G, c);
      EpiPe E{(bf16_t*)(ws + OFF_G), (const float*)(ws + OFF_SSQ), (float*)(ws + OFF_TOT)};
      pg8::gemm_phase(L, g, S, E, rep == 0 ? &xb : nullptr); }
    { pg8::Gemm g{(const bf16_t*)(ws + OFF_XR), (const bf16_t*)(ws + OFF_WPG), MROWS, DM, DM}; S.init(MROWS, DM, G, c);
      EpiFinal E{(const bf16_t*)(ws + OFF_G), (const float*)(ws + OFF_TOT), P.b_ple_gate, P.out, (const bf16_t*)(ws + OFF_XR)};
      pg8::gemm_phase(L, g, S, E); } }
}

extern "C" void kernel_launch(void* const* d_in, const int* in_sizes, int n_in, void* d_out, int out_size, void* d_ws, size_t ws_size, hipStream_t stream) {
    static int grid_blocks = 0;
    if (grid_blocks == 0) {
        if (n_in != 21 || in_sizes[0] != MROWS * DM || out_size != MROWS * DM || ws_size < WS_END) { fprintf(stderr, "kernel_launch: unexpected shapes / workspace (n_in %d, ws %zu, need %zu)\n", n_in, ws_size, (size_t)WS_END); grid_blocks = -1; return; }
        int dev = 0, cus = 0, per_cu = 0;
        (void)hipGetDevice(&dev);
        (void)hipDeviceGetAttribute(&cus, hipDeviceAttributeMultiprocessorCount, dev);
        if (hipFuncSetAttribute((const void*)fwd_megakernel, hipFuncAttributeMaxDynamicSharedMemorySize, LDS_BYTES) != hipSuccess) { fprintf(stderr, "kernel_launch: hipFuncSetAttribute failed\n"); grid_blocks = -1; return; }
        if (hipOccupancyMaxActiveBlocksPerMultiprocessor(&per_cu, (const void*)fwd_megakernel, 512, LDS_BYTES) != hipSuccess || per_cu < 1) { fprintf(stderr, "kernel_launch: occupancy query failed (%d)\n", per_cu); per_cu = 1; (void)hipGetLastError(); }
        grid_blocks = cus * 1;
    }
    if (grid_blocks < 0) return;
    Params P{};
    P.x = (const float*)d_in[0]; P.p = (const float*)d_in[1]; P.norm_mix = (const float*)d_in[2]; P.w_in = (const float*)d_in[3]; P.b_in = (const float*)d_in[4];
    P.conv_w = (const float*)d_in[5]; P.conv_b = (const float*)d_in[6]; P.w_rg_a = (const float*)d_in[7]; P.b_rg_a = (const float*)d_in[8]; P.w_rg_x = (const float*)d_in[9]; P.b_rg_x = (const float*)d_in[10];
    P.lam = (const float*)d_in[11]; P.q_norm = (const float*)d_in[12]; P.k_norm = (const float*)d_in[13]; P.w_o_rnn = (const float*)d_in[14]; P.w_o_att = (const float*)d_in[15]; P.w_out = (const float*)d_in[16];
    P.norm_ple = (const float*)d_in[17]; P.w_ple_gate = (const float*)d_in[18]; P.b_ple_gate = (const float*)d_in[19]; P.w_ple = (const float*)d_in[20];
    P.out = (float*)d_out; P.ws = (unsigned char*)d_ws;
    if (hipMemsetAsync((char*)d_ws + OFF_CTR, 0, OFF_HN - OFF_CTR, stream) != hipSuccess) { fprintf(stderr, "kernel_launch: hipMemsetAsync of the barrier / queue words failed\n"); return; }
    void* args[] = {&P};
    hipError_t e = hipLaunchCooperativeKernel((const void*)fwd_megakernel, dim3(grid_blocks), dim3(512), args, LDS_BYTES, stream);
    if (e != hipSuccess) fprintf(stderr, "cooperative launch failed: %s (grid %d)\n", hipGetErrorString(e), grid_blocks);
}
```

```cpp
#include <hip/hip_runtime.h>
#include <hip/hip_cooperative_groups.h>
#include <cstdio>
namespace cg = cooperative_groups;

#define LAS __attribute__((address_space(3)))
typedef unsigned short bf16_t;
typedef short bf16x8 __attribute__((ext_vector_type(8)));
typedef float f32x4 __attribute__((ext_vector_type(4)));
typedef unsigned u32x4 __attribute__((ext_vector_type(4)));
typedef unsigned u32x2 __attribute__((ext_vector_type(2)));

constexpr int MROWS = 32768, SEQ = 2048, DM = 1024, DRNN = 1280, NIN = 9728, PLE = 256, QKVW = 4608, ATTW = 512;
constexpr int NA = 6144;
constexpr int NB = 3584;
constexpr float EPS = 1e-6f;

constexpr size_t al256(size_t x) { return (x + 255) & ~(size_t)255; }
constexpr size_t OFF_WIN = 0;
constexpr size_t OFF_WR = al256(OFF_WIN + (size_t)NIN * DM * 2);
constexpr size_t OFF_WA = al256(OFF_WR + (size_t)DM * DRNN * 2);
constexpr size_t OFF_WOUT = al256(OFF_WA + (size_t)DM * ATTW * 2);
constexpr size_t OFF_WPG = al256(OFF_WOUT + (size_t)DM * DM * 2);
constexpr size_t OFF_WPE = al256(OFF_WPG + (size_t)DM * DM * 2);
constexpr size_t OFF_WGA = al256(OFF_WPE + (size_t)DM * PLE * 2);
constexpr size_t OFF_WGX = al256(OFF_WGA + (size_t)10 * 128 * 128 * 2);
constexpr size_t OFF_BIN = al256(OFF_WGX + (size_t)10 * 128 * 128 * 2);
constexpr size_t OFF_ROPE = al256(OFF_BIN + (size_t)NIN * 4);
constexpr size_t OFF_TOT = al256(OFF_ROPE + (size_t)2 * SEQ * 64 * 4);
constexpr size_t OFF_LSE = al256(OFF_TOT + (size_t)16 * 16 * DRNN * 2 * 4);
constexpr size_t OFF_SSQ = al256(OFF_LSE + (size_t)3 * MROWS * 4 * 4);
constexpr size_t OFF_CTR = al256(OFF_SSQ + (size_t)MROWS * 16 * 4);
constexpr size_t OFF_BAR = al256(OFF_CTR + 256);
constexpr size_t OFF_HN = al256(OFF_BAR + 3456 * 4);
constexpr size_t OFF_PB = al256(OFF_HN + (size_t)MROWS * DM * 2);
constexpr size_t OFF_XR = al256(OFF_PB + (size_t)MROWS * PLE * 2);
constexpr size_t OFF_R = al256(OFF_XR + (size_t)MROWS * DRNN * 2);
constexpr size_t OFF_ZR = OFF_R;
constexpr size_t OFF_ZA = al256(OFF_ZR + (size_t)MROWS * DRNN * 2);
constexpr size_t OFF_G = al256(OFF_ZA + (size_t)MROWS * ATTW * 2);
constexpr size_t OFF_GX = al256(OFF_R + (size_t)MROWS * QKVW * 2);
constexpr size_t WS_END = al256(OFF_GX + (size_t)MROWS * 256 * 2);
static_assert(OFF_G + (size_t)MROWS * 2048 * 2 <= WS_END, "region R too small");
static_assert(WS_END <= (size_t)536870912, "workspace over 512 MiB");

constexpr int GAIN_OFF = 4 * 128 * 272 + 1536;
constexpr int LDS_BYTES = 4 * 128 * 272 + 1536 + 3072 + 16;
constexpr int KS_STRIDE = 272, VT_STRIDE = 528, XC_STRIDE = 272;
constexpr int VT_OFF = 256 * KS_STRIDE;

struct Params {
    const float *x, *p, *norm_mix, *w_in, *b_in, *conv_w, *conv_b, *w_rg_a, *b_rg_a, *w_rg_x, *b_rg_x, *lam, *q_norm, *k_norm, *w_o_rnn, *w_o_att, *w_out, *norm_ple, *w_ple_gate, *b_ple_gate, *w_ple;
    float* out; unsigned char* ws;
};

__device__ __forceinline__ unsigned pk2(float lo, float hi) { unsigned r; asm volatile("v_cvt_pk_bf16_f32 %0, %1, %2" : "=v"(r) : "v"(lo), "v"(hi)); return r; }
__device__ __forceinline__ float bflo(unsigned w) { return __uint_as_float(w << 16); }
__device__ __forceinline__ float bfhi(unsigned w) { return __uint_as_float(w & 0xffff0000u); }
__device__ __forceinline__ float bf2f(bf16_t b) { return __uint_as_float(((unsigned)b) << 16); }
__device__ __forceinline__ float wave_sum(float v) {
#pragma unroll
    for (int o = 1; o < 64; o <<= 1) v += __shfl_xor(v, o);
    return v;
}
__device__ __forceinline__ float sigmoidf_(float v) { return __builtin_amdgcn_rcpf(1.0f + __expf(-v)); }
__device__ __forceinline__ float siluf_(float v) { return v * __builtin_amdgcn_rcpf(1.0f + __expf(-v)); }
#define LDS_WAIT() asm volatile("s_waitcnt lgkmcnt(0)" ::: "memory")

#define XB_TMO      128
#define XB_XCNT(j)  (256  + 64 * (j))
#define XB_XSUB(j)  (1280 + 64 * (j))
#define XB_XGEN(j)  (2304 + 64 * (j))
#define XB_TOP      3328
#define XB_TOPGEN   3392
#define XCD_BAR_WORDS 3456
#define XB_SPIN_CAP (1u << 18)
__device__ __forceinline__ unsigned xb_ld(unsigned* p)              { return __hip_atomic_load(p, __ATOMIC_RELAXED, __HIP_MEMORY_SCOPE_AGENT); }
__device__ __forceinline__ unsigned xb_add(unsigned* p, unsigned v) { return __hip_atomic_fetch_add(p, v, __ATOMIC_RELAXED, __HIP_MEMORY_SCOPE_AGENT); }
__device__ __forceinline__ unsigned xb_xcc_id() { return (unsigned)__builtin_amdgcn_s_getreg((3 << 11) | 20) & 0xFu; }
#define XB_SPIN(cond, bar) do { unsigned _sp = 0; while (cond) { __builtin_amdgcn_s_sleep(1); \
    if ((++_sp & 255u) == 0u) { if (xb_ld(&(bar)[XB_TMO])) break; if (_sp > XB_SPIN_CAP) { atomicAdd(&(bar)[XB_TMO], 1u); break; } } } } while (0)
struct XcdBarrier { unsigned* bar; unsigned x; volatile LAS unsigned* st; };
__device__ __forceinline__ XcdBarrier xcd_barrier_post(unsigned* bar, volatile LAS unsigned* st) {
    XcdBarrier b; b.bar = bar; b.x = xb_xcc_id(); b.st = st;
    if (threadIdx.x == 0) (void)xb_add(&bar[XB_XCNT(b.x)], 1u);
    return b;
}
__device__ __forceinline__ void xcd_barrier_complete(unsigned* bar, unsigned x, unsigned& nloc, unsigned& nx) {
    const unsigned G = gridDim.x * gridDim.y * gridDim.z;
    unsigned sum, cnt, mine, sp = 0u;
    for (;;) {
        sum = 0u; cnt = 0u; mine = 0u;
#pragma unroll
        for (unsigned j = 0; j < 16; ++j) { const unsigned c = xb_ld(&bar[XB_XCNT(j)]); sum += c; cnt += (c > 0u) ? 1u : 0u; mine = (j == x) ? c : mine; }
        if (sum == G) break;
        __builtin_amdgcn_s_sleep(1);
        if ((++sp & 255u) == 0u) { if (xb_ld(&bar[XB_TMO])) break; if (sp > XB_SPIN_CAP) { atomicAdd(&bar[XB_TMO], 1u); break; } }
    }
    nloc = mine > 0u ? mine : 1u; nx = cnt > 0u ? cnt : 1u;
}
__device__ __forceinline__ void xcd_barrier(const XcdBarrier& b) {
    asm volatile("s_waitcnt vmcnt(0)" ::: "memory");
    __syncthreads();
    if (threadIdx.x == 0) {
        unsigned* bar = b.bar;
        __builtin_amdgcn_s_waitcnt(0);
        unsigned nloc = b.st[0], nx = b.st[1];
        if (nloc == 0u) { xcd_barrier_complete(bar, b.x, nloc, nx); b.st[0] = nloc; b.st[1] = nx; }
        const unsigned old = xb_add(&bar[XB_XSUB(b.x)], 1u);
        const unsigned gen = old / nloc;
        if (old + 1u == (gen + 1u) * nloc) {
            __builtin_amdgcn_fence(__ATOMIC_RELEASE, "agent");
            asm volatile("s_waitcnt vmcnt(0)" ::: "memory");
            const unsigned og = xb_add(&bar[XB_TOP], 1u);
            const unsigned tg = og / nx;
            if (og + 1u == (tg + 1u) * nx) xb_add(&bar[XB_TOPGEN], 1u);
            else XB_SPIN(xb_ld(&bar[XB_TOPGEN]) == tg, bar);
            __builtin_amdgcn_fence(__ATOMIC_ACQUIRE, "agent");
            xb_add(&bar[XB_XGEN(b.x)], 1u);
            asm volatile("s_waitcnt vmcnt(0)" ::: "memory");
        } else {
            XB_SPIN(xb_ld(&bar[XB_XGEN(b.x)]) == gen, bar);
            __builtin_amdgcn_fence(__ATOMIC_ACQUIRE, "agent");
            asm volatile("s_waitcnt vmcnt(0)" ::: "memory");
        }
    }
    __syncthreads();
}

namespace pg8 {
constexpr int BM = 256, BK = 64, HALF = 128, HTB = HALF * BK * 2, STAGE_BYTES = 8 * HTB, NXCD = 8, WGM = 8;
__host__ __device__ __forceinline__ int lds_byte(int r, int c) { const int st = (r >> 4) * 2 + (c >> 5), rr = r & 15, cc = c & 31, ob = rr * 64 + cc * 2; return st * 1024 + (ob ^ (((ob >> 9) & 1) << 5)); }
__host__ __device__ __forceinline__ void stage_rc(int b, int& R, int& C) { const int st = b / 1024, sb = b % 1024, swz = sb ^ (((sb >> 9) & 1) << 5); R = (st >> 1) * 16 + swz / 64; C = (st & 1) * 32 + (swz % 64) / 2; }
__host__ __device__ __forceinline__ int perm32(int rho) { const int n = rho >> 4, i = rho & 15; return 8 * (i >> 2) + 4 * n + (i & 3); }
struct Unit { int pm, pn; };
struct Gemm { const bf16_t* A; const bf16_t* Bt; int M, N, K; };
struct StaticOrder {
    int nM, nN, nwg, G, c;
    __device__ void init(int M, int N, int G_, int c_) { nM = M / BM; nN = N / BM; nwg = nM * nN; G = G_; c = c_; }
    __device__ bool next(int i, Unit& u) const {
        const long L = (long)i * G + c; if (L >= nwg) return false;
        int wgid = (int)L; { const int q = nwg / NXCD, r = nwg % NXCD, xcd = wgid % NXCD, off = wgid / NXCD; wgid = (xcd < r ? xcd * (q + 1) : r * (q + 1) + (xcd - r) * q) + off; }
        const int nig = WGM * nN, gid = wgid / nig, fm = gid * WGM, gsz = (nM - fm) < WGM ? (nM - fm) : WGM;
        u.pm = fm + ((wgid % nig) % gsz); u.pn = (wgid % nig) / gsz; return true;
    }
};

template <class Epi>
__device__ __forceinline__ void gemm_phase(LAS unsigned char* lds, const Gemm g, const StaticOrder& S, const Epi& E, const XcdBarrier* pre = nullptr) {
    int tid = threadIdx.x; asm volatile("" : "+v"(tid));
    const int wid = __builtin_amdgcn_readfirstlane(tid >> 6), lane = tid & 63, wr = wid >> 2, wc = wid & 3, fr = lane & 15, fq = lane >> 4;
    int K = g.K; asm volatile("" : "+s"(K)); const int nt = K / BK;
    unsigned voffA[2], voffB[2];
#pragma unroll
    for (int i = 0; i < 2; ++i) { int R, C; stage_rc(tid * 16 + i * 8192, R, C); const int Rb = Epi::PERM ? ((R & ~31) + perm32(R & 31)) : R;
        voffA[i] = (unsigned)(R * K + C) * 2u; voffB[i] = (unsigned)(Rb * K + C) * 2u; }
    const size_t kstep = (size_t)(BK * 2);
    const size_t hstep = (size_t)HALF * K * 2;
    const size_t tstep = 2 * hstep;
    const unsigned ldsw = (unsigned)wid * 1024u;
    const int aoff = lds_byte(wr * 64 + fr, fq * 8), boff = lds_byte(wc * 32 + fr, fq * 8);
#define PG8_SA(b, h) (((b) * 2 + (h)) * HTB)
#define PG8_SB(b, h) ((4 + (b) * 2 + (h)) * HTB)
#define PG8_STAGE(bufoff, gbase, voff) do { _Pragma("unroll") for (int _i = 0; _i < 2; ++_i) \
        __builtin_amdgcn_global_load_lds((const unsigned*)((const char*)(gbase) + (voff)[_i]), (LAS unsigned*)(lds + (bufoff) + ldsw + _i * 8192), 16, 0, 0); } while (0)
#define PG8_LDA(dst, b, h) do { _Pragma("unroll") for (int m = 0; m < 4; ++m) _Pragma("unroll") for (int k = 0; k < 2; ++k) dst[m][k] = *(const LAS bf16x8*)(lds + PG8_SA(b, h) + aoff + m * 2048 + k * 1024); } while (0)
#define PG8_LDB(dst, b, h) do { _Pragma("unroll") for (int n = 0; n < 2; ++n) _Pragma("unroll") for (int k = 0; k < 2; ++k) dst[n][k] = *(const LAS bf16x8*)(lds + PG8_SB(b, h) + boff + n * 2048 + k * 1024); } while (0)
#define PG8_MMA(ai, bj, At, Bt) do { __builtin_amdgcn_s_setprio(1); _Pragma("unroll") for (int m = 0; m < 4; ++m) _Pragma("unroll") for (int n = 0; n < 2; ++n) _Pragma("unroll") for (int k = 0; k < 2; ++k) \
        acc[ai][bj][m][n] = __builtin_amdgcn_mfma_f32_16x16x32_bf16(Bt[n][k], At[m][k], acc[ai][bj][m][n], 0, 0, 0); __builtin_amdgcn_s_setprio(0); } while (0)
#define PG8_WAIT_V(n) asm volatile("s_waitcnt vmcnt(" #n ")" ::: "memory")
#define PG8_WAIT_L(n) asm volatile("s_waitcnt lgkmcnt(" #n ")" ::: "memory")
#define PG8_BAR __builtin_amdgcn_s_barrier()
#define PG8_SCHED __builtin_amdgcn_sched_barrier(0)
    Unit cur, nxt; int ui = 0;
    if (!S.next(0, cur)) { if (pre) xcd_barrier(*pre); return; }
    f32x4 acc[2][2][4][2];
#pragma unroll
    for (int a = 0; a < 2; ++a)
#pragma unroll
        for (int b = 0; b < 2; ++b)
#pragma unroll
            for (int m = 0; m < 4; ++m)
#pragma unroll
                for (int n = 0; n < 2; ++n) acc[a][b][m][n] = (f32x4){0.f, 0.f, 0.f, 0.f};
    bf16x8 At[4][2], B0[2][2], B1[2][2];
    f32x4 bvp[2][2];
#pragma unroll
    for (int bj = 0; bj < 2; ++bj)
#pragma unroll
        for (int n = 0; n < 2; ++n) bvp[bj][n] = (f32x4){0.f, 0.f, 0.f, 0.f};
    const char* cA = (const char*)g.A + (size_t)cur.pm * tstep; const char* cB = (const char*)g.Bt + (size_t)cur.pn * tstep;
    if (pre) {
        __syncthreads();
        PG8_STAGE(PG8_SB(0, 0), cB, voffB); PG8_STAGE(PG8_SB(0, 1), cB + hstep, voffB);
        xcd_barrier(*pre);
        PG8_STAGE(PG8_SA(0, 0), cA, voffA); PG8_STAGE(PG8_SA(0, 1), cA + hstep, voffA);
        if (wr == 1) PG8_BAR;
        PG8_WAIT_V(2); PG8_BAR;
    } else {
        PG8_STAGE(PG8_SB(0, 0), cB, voffB); PG8_STAGE(PG8_SA(0, 0), cA, voffA); PG8_STAGE(PG8_SB(0, 1), cB + hstep, voffB); PG8_STAGE(PG8_SA(0, 1), cA + hstep, voffA);
        if (wr == 1) PG8_BAR;
        PG8_WAIT_V(4); PG8_BAR;
    }
    PG8_STAGE(PG8_SB(1, 0), cB + kstep, voffB); PG8_STAGE(PG8_SA(1, 0), cA + kstep, voffA); PG8_STAGE(PG8_SB(1, 1), cB + hstep + kstep, voffB);
    PG8_WAIT_V(6); PG8_BAR;
    for (;;) {
        const bool has_next = S.next(ui + 1, nxt);
        const char* nA = has_next ? (const char*)g.A + (size_t)nxt.pm * tstep : cA; const char* nB = has_next ? (const char*)g.Bt + (size_t)nxt.pn * tstep : cB;
        for (int t = 0; t < nt; t += 2) {
            if constexpr (Epi::MID_T > 0) { if (t == Epi::MID_T) E.mid(acc, cur, wr, wc, fr, fq); }
            const bool last = (t == nt - 2);
            if constexpr (Epi::HAS_BIAS) { if (last) { const float* bp = E.bias + cur.pn * 256 + wc * 32 + 8 * fq;
#pragma unroll
                for (int bj = 0; bj < 2; ++bj)
#pragma unroll
                    for (int n = 0; n < 2; ++n) bvp[bj][n] = *(const f32x4*)(bp + bj * 128 + 4 * n); } }
            const char* a1 = cA + (size_t)(t + 1) * kstep;
            const char* a2 = last ? nA : cA + (size_t)(t + 2) * kstep; const char* b2 = last ? nB : cB + (size_t)(t + 2) * kstep;
            const char* a3 = a2 + kstep; const char* b3 = b2 + kstep;
            PG8_LDB(B0, 0, 0); PG8_SCHED; PG8_LDA(At, 0, 0); PG8_STAGE(PG8_SA(1, 1), a1 + hstep, voffA);
            PG8_WAIT_L(8); PG8_BAR; PG8_WAIT_L(0); PG8_MMA(0, 0, At, B0); PG8_BAR; PG8_SCHED;
            PG8_LDB(B1, 0, 1); PG8_STAGE(PG8_SB(0, 0), b2, voffB);
            PG8_BAR; PG8_WAIT_L(0); PG8_MMA(0, 1, At, B1); PG8_BAR;
            PG8_LDA(At, 0, 1); PG8_STAGE(PG8_SA(0, 0), a2, voffA);
            PG8_BAR; PG8_WAIT_L(0); PG8_MMA(1, 0, At, B0); PG8_BAR; PG8_SCHED;
            PG8_STAGE(PG8_SB(0, 1), b2 + hstep, voffB);
            PG8_WAIT_V(6); PG8_BAR; PG8_MMA(1, 1, At, B1); PG8_BAR;
            PG8_LDB(B0, 1, 0); PG8_SCHED; PG8_LDA(At, 1, 0); PG8_STAGE(PG8_SA(0, 1), a2 + hstep, voffA);
            PG8_WAIT_L(8); PG8_BAR; PG8_WAIT_L(0); PG8_MMA(0, 0, At, B0); PG8_BAR; PG8_SCHED;
            PG8_LDB(B1, 1, 1); PG8_STAGE(PG8_SB(1, 0), b3, voffB);
            PG8_BAR; PG8_WAIT_L(0); PG8_MMA(0, 1, At, B1); PG8_BAR;
            PG8_LDA(At, 1, 1); PG8_STAGE(PG8_SA(1, 0), a3, voffA);
            PG8_BAR; PG8_WAIT_L(0); PG8_MMA(1, 0, At, B0); PG8_BAR; PG8_SCHED;
            PG8_STAGE(PG8_SB(1, 1), b3 + hstep, voffB);
            PG8_WAIT_V(6); PG8_BAR; PG8_MMA(1, 1, At, B1); PG8_BAR;
        }
        if constexpr (Epi::HAS_BIAS) E(acc, cur, wr, wc, fr, fq, bvp); else E(acc, cur, wr, wc, fr, fq);
        if (!has_next) break;
#pragma unroll
        for (int a = 0; a < 2; ++a)
#pragma unroll
            for (int b = 0; b < 2; ++b)
#pragma unroll
                for (int m = 0; m < 4; ++m)
#pragma unroll
                    for (int n = 0; n < 2; ++n) acc[a][b][m][n] = (f32x4){0.f, 0.f, 0.f, 0.f};
        cur = nxt; cA = nA; cB = nB; ++ui;
    }
    PG8_WAIT_V(0);
    if (wr == 0) PG8_BAR;
    PG8_BAR;
#undef PG8_SA
#undef PG8_SB
#undef PG8_STAGE
#undef PG8_LDA
#undef PG8_LDB
#undef PG8_MMA
#undef PG8_WAIT_V
#undef PG8_WAIT_L
#undef PG8_BAR
#undef PG8_SCHED
}
}
using pg8::Unit;

template <int WHICH> struct EpiProj {
    static constexpr bool PERM = true; static constexpr int MID_T = 0; static constexpr bool HAS_BIAS = true;
    const float* bias;
    unsigned char* ws; const void* ogp;
    __device__ __forceinline__ void operator()(const f32x4 (&acc)[2][2][4][2], const Unit& u, int wr, int wc, int fr, int fq, const f32x4 (&bv)[2][2]) const {
        constexpr int pnb0 = 5, pnb1 = WHICH == 0 ? 23 : 7;
        const int t = u.pn < pnb0 ? 0 : (u.pn < pnb1 ? 1 : 2);
        const size_t off = WHICH == 0 ? (t == 0 ? OFF_XR : (t == 1 ? OFF_R : OFF_GX)) : (t == 2 ? OFF_G : OFF_ZR);
        const int ld = WHICH == 0 ? (t == 0 ? DRNN : (t == 1 ? QKVW : 256)) : (t == 2 ? 2048 : 1792);
        const int cbase = WHICH == 1 ? (t == 1 ? DRNN : (t == 2 ? 256 : 0)) : 0;
        bf16_t* base = (bf16_t*)(ws + off);
        const int colt = (u.pn - (t == 0 ? 0 : (t == 1 ? pnb0 : pnb1))) * 256;
        const int row0 = u.pm * 256 + wr * 64 + fr, col0 = colt + wc * 32 + 8 * fq, bcol0 = u.pn * 256 + wc * 32 + 8 * fq;
        const bool sig = (WHICH == 0 && t == 2) || (WHICH == 1 && t == 2);
        if (WHICH == 1 && t == 0) {
#pragma unroll
            for (int ai = 0; ai < 2; ++ai) {
                u32x4 hh[4][2];
#pragma unroll
                for (int m = 0; m < 4; ++m)
#pragma unroll
                    for (int bj = 0; bj < 2; ++bj) hh[m][bj] = *(const u32x4*)((const bf16_t*)(ws + OFF_XR) + (size_t)(row0 + ai * 128 + m * 16) * DRNN + col0 + bj * 128);
#pragma unroll
                for (int m = 0; m < 4; ++m) { bf16_t* rowp = base + (size_t)(row0 + ai * 128 + m * 16) * ld + col0 + cbase;
#pragma unroll
                    for (int bj = 0; bj < 2; ++bj) { const f32x4 v0 = acc[ai][bj][m][0] + bv[bj][0], v1 = acc[ai][bj][m][1] + bv[bj][1]; const u32x4 q = hh[m][bj];
                        u32x4 w; w.x = pk2(siluf_(v0[0]) * bflo(q.x), siluf_(v0[1]) * bfhi(q.x)); w.y = pk2(siluf_(v0[2]) * bflo(q.y), siluf_(v0[3]) * bfhi(q.y));
                        w.z = pk2(siluf_(v1[0]) * bflo(q.z), siluf_(v1[1]) * bfhi(q.z)); w.w = pk2(siluf_(v1[2]) * bflo(q.w), siluf_(v1[3]) * bfhi(q.w));
                        *(u32x4*)(rowp + bj * 128) = w; } }
                asm volatile("" ::: "memory"); }
            return; }
#pragma unroll
        for (int ai = 0; ai < 2; ++ai)
#pragma unroll
        for (int mh = 0; mh < 2; ++mh) {
            f32x4 mul[2][2][2];
            if (WHICH == 1 && t == 1) {
                const float* LSE = (const float*)(ws + OFF_LSE); const bf16_t* OG = (const bf16_t*)ogp;
                u32x4 og[2][2][3]; float ls[2][2][3];
#pragma unroll
                for (int mm = 0; mm < 2; ++mm)
#pragma unroll
                    for (int bj = 0; bj < 2; ++bj) { const size_t row = (size_t)(row0 + ai * 128 + (2 * mh + mm) * 16); const int col = col0 + bj * 128, hd = col >> 7;
#pragma unroll
                        for (int gq = 0; gq < 3; ++gq) { og[mm][bj][gq] = *(const u32x4*)(OG + ((size_t)gq * MROWS + row) * ATTW + col); ls[mm][bj][gq] = LSE[((size_t)gq * MROWS + row) * 4 + hd]; } }
#pragma unroll
                for (int mm = 0; mm < 2; ++mm)
#pragma unroll
                    for (int bj = 0; bj < 2; ++bj) { const float l0 = ls[mm][bj][0], l1 = ls[mm][bj][1], l2 = ls[mm][bj][2];
                        const float mxl = fmaxf(l0, fmaxf(l1, l2)); float w0 = __expf(l0 - mxl), w1 = __expf(l1 - mxl), w2 = __expf(l2 - mxl); const float inv = __builtin_amdgcn_rcpf(w0 + w1 + w2); w0 *= inv; w1 *= inv; w2 *= inv;
                        const u32x4 o0 = og[mm][bj][0], o1 = og[mm][bj][1], o2 = og[mm][bj][2];
                        mul[mm][bj][0] = (f32x4){w0 * bflo(o0.x) + w1 * bflo(o1.x) + w2 * bflo(o2.x), w0 * bfhi(o0.x) + w1 * bfhi(o1.x) + w2 * bfhi(o2.x), w0 * bflo(o0.y) + w1 * bflo(o1.y) + w2 * bflo(o2.y), w0 * bfhi(o0.y) + w1 * bfhi(o1.y) + w2 * bfhi(o2.y)};
                        mul[mm][bj][1] = (f32x4){w0 * bflo(o0.z) + w1 * bflo(o1.z) + w2 * bflo(o2.z), w0 * bfhi(o0.z) + w1 * bfhi(o1.z) + w2 * bfhi(o2.z), w0 * bflo(o0.w) + w1 * bflo(o1.w) + w2 * bflo(o2.w), w0 * bfhi(o0.w) + w1 * bfhi(o1.w) + w2 * bfhi(o2.w)}; } }
            if (sig) {
                const int gj = WHICH == 0 ? 0 : u.pn - 6;
                bf16_t* Rb = WHICH == 0 ? (bf16_t*)(ws + OFF_GX) : (bf16_t*)(ws + OFF_G); const int ldg = WHICH == 0 ? 128 : 1024;
                bf16_t* Gb = Rb + (size_t)MROWS * ldg; const int gcol = (WHICH == 0 ? 0 : gj * 128) + wc * 32 + 8 * fq;
#pragma unroll
                for (int mm = 0; mm < 2; ++mm) { const int m = 2 * mh + mm; const size_t row = (size_t)(row0 + ai * 128 + m * 16);
                    u32x4 wr_, wg_; float rr[8], gg[8];
#pragma unroll
                    for (int n = 0; n < 2; ++n)
#pragma unroll
                        for (int j = 0; j < 4; ++j) { const float a0 = acc[ai][0][m][n][j] + bv[0][n][j], a1 = acc[ai][1][m][n][j] + bv[1][n][j];
                            const float d0 = 1.0f + __expf(-a0), d1 = 1.0f + __expf(-a1);
                            gg[4 * n + j] = __builtin_amdgcn_rcpf(d1); rr[4 * n + j] = d1 * __builtin_amdgcn_rcpf(d0); }
                    wr_.x = pk2(rr[0], rr[1]); wr_.y = pk2(rr[2], rr[3]); wr_.z = pk2(rr[4], rr[5]); wr_.w = pk2(rr[6], rr[7]);
                    wg_.x = pk2(gg[0], gg[1]); wg_.y = pk2(gg[2], gg[3]); wg_.z = pk2(gg[4], gg[5]); wg_.w = pk2(gg[6], gg[7]);
                    *(u32x4*)(Rb + row * ldg + gcol) = wr_; *(u32x4*)(Gb + row * ldg + gcol) = wg_; }
                continue; }
#pragma unroll
            for (int mm = 0; mm < 2; ++mm) { const int m = 2 * mh + mm; bf16_t* rowp = base + (size_t)(row0 + ai * 128 + m * 16) * ld + col0 + cbase;
#pragma unroll
                for (int bj = 0; bj < 2; ++bj) { f32x4 v0 = acc[ai][bj][m][0] + bv[bj][0], v1 = acc[ai][bj][m][1] + bv[bj][1];
                    if (WHICH == 1) {
#pragma unroll
                        for (int j = 0; j < 4; ++j) { v0[j] = siluf_(v0[j]) * mul[mm][bj][0][j]; v1[j] = siluf_(v1[j]) * mul[mm][bj][1][j]; } }
                    u32x4 w; w.x = pk2(v0[0], v0[1]); w.y = pk2(v0[2], v0[3]); w.z = pk2(v1[0], v1[1]); w.w = pk2(v1[2], v1[3]);
                    *(u32x4*)(rowp + bj * 128) = w; } }
            if (WHICH == 1) asm volatile("" ::: "memory"); }
    }
};
struct EpiMergeFused {
    static constexpr bool PERM = true; static constexpr int MID_T = 20; static constexpr bool HAS_BIAS = false;
    const bf16_t* G; bf16_t* MG; const bf16_t* GX;
    __device__ __forceinline__ void mid(f32x4 (&acc)[2][2][4][2], const Unit& u, int wr, int wc, int fr, int fq) const {
        int frx = fr, fqx = fq; asm volatile("" : "+v"(frx), "+v"(fqx));
        const int row0 = u.pm * 256 + wr * 64 + frx, col0 = u.pn * 256 + wc * 32 + 8 * fqx;
        u32x4 rq[2][4][2];
#pragma unroll
        for (int ai = 0; ai < 2; ++ai)
#pragma unroll
            for (int m = 0; m < 4; ++m)
#pragma unroll
                for (int bj = 0; bj < 2; ++bj) { const size_t row = (size_t)(row0 + ai * 128 + m * 16); const int col = col0 + bj * 128;
                    rq[ai][m][bj] = *(const u32x4*)((bj == 0 && u.pn == 0) ? GX + row * 128 + col : G + row * 1024 + col); }
#pragma unroll
        for (int ai = 0; ai < 2; ++ai)
#pragma unroll
            for (int m = 0; m < 4; ++m)
#pragma unroll
                for (int bj = 0; bj < 2; ++bj) { const u32x4 a = rq[ai][m][bj];
                    acc[ai][bj][m][0] *= (f32x4){bflo(a.x), bfhi(a.x), bflo(a.y), bfhi(a.y)}; acc[ai][bj][m][1] *= (f32x4){bflo(a.z), bfhi(a.z), bflo(a.w), bfhi(a.w)}; }
        asm volatile("" ::: "memory");
    }
    __device__ __forceinline__ void operator()(const f32x4 (&acc)[2][2][4][2], const Unit& u, int wr, int wc, int fr, int fq) const {
        const int row0 = u.pm * 256 + wr * 64 + fr, col0 = u.pn * 256 + wc * 32 + 8 * fq;
        const bf16_t* G1 = G + (size_t)MROWS * 1024; const bf16_t* GX1 = GX + (size_t)MROWS * 128;
        u32x4 gg[2][4][2];
#pragma unroll
        for (int ai = 0; ai < 2; ++ai)
#pragma unroll
            for (int m = 0; m < 4; ++m)
#pragma unroll
                for (int bj = 0; bj < 2; ++bj) { const size_t row = (size_t)(row0 + ai * 128 + m * 16); const int col = col0 + bj * 128;
                    gg[ai][m][bj] = *(const u32x4*)((bj == 0 && u.pn == 0) ? GX1 + row * 128 + col : G1 + row * 1024 + col); }
#pragma unroll
        for (int ai = 0; ai < 2; ++ai)
#pragma unroll
            for (int m = 0; m < 4; ++m) { const size_t row = (size_t)(row0 + ai * 128 + m * 16);
#pragma unroll
                for (int bj = 0; bj < 2; ++bj) { const int col = col0 + bj * 128; const u32x4 q = gg[ai][m][bj];
                    const f32x4 a0 = acc[ai][bj][m][0], a1 = acc[ai][bj][m][1];
                    u32x4 w; w.x = pk2(a0[0] * bflo(q.x), a0[1] * bfhi(q.x)); w.y = pk2(a0[2] * bflo(q.y), a0[3] * bfhi(q.y));
                    w.z = pk2(a1[0] * bflo(q.z), a1[1] * bfhi(q.z)); w.w = pk2(a1[2] * bflo(q.w), a1[3] * bfhi(q.w));
                    *(u32x4*)(MG + row * 1024 + col) = w; } }
    }
};
struct EpiX1 {
    static constexpr bool PERM = true; static constexpr int MID_T = 0; static constexpr bool HAS_BIAS = false;
    const float* x; float* X1; bf16_t* X1B; float* SSQ;
    __device__ __forceinline__ void operator()(const f32x4 (&acc)[2][2][4][2], const Unit& u, int wr, int wc, int fr, int fq) const {
        const int row0 = u.pm * 256 + wr * 64 + fr, col0 = u.pn * 256 + wc * 32 + 8 * fq;
#pragma unroll
        for (int ai = 0; ai < 2; ++ai) {
            f32x4 xv[4][2][2];
#pragma unroll
            for (int m = 0; m < 4; ++m)
#pragma unroll
                for (int bj = 0; bj < 2; ++bj) { const size_t o = (size_t)(row0 + ai * 128 + m * 16) * 1024 + col0 + bj * 128; xv[m][bj][0] = *(const f32x4*)(x + o); xv[m][bj][1] = *(const f32x4*)(x + o + 4); }
#pragma unroll
            for (int m = 0; m < 4; ++m) { const size_t row = (size_t)(row0 + ai * 128 + m * 16); float ss = 0.f;
#pragma unroll
                for (int bj = 0; bj < 2; ++bj) { const size_t o = row * 1024 + col0 + bj * 128;
                    const f32x4 v0 = xv[m][bj][0] + acc[ai][bj][m][0], v1 = xv[m][bj][1] + acc[ai][bj][m][1];
                    u32x4 w; w.x = pk2(v0[0], v0[1]); w.y = pk2(v0[2], v0[3]); w.z = pk2(v1[0], v1[1]); w.w = pk2(v1[2], v1[3]);
                    *(u32x4*)(X1B + o) = w;
                    ss += (v0[0] * v0[0] + v0[1] * v0[1]) + (v0[2] * v0[2] + v0[3] * v0[3]) + (v1[0] * v1[0] + v1[1] * v1[1]) + (v1[2] * v1[2] + v1[3] * v1[3]); }
                ss += __shfl_xor(ss, 16); ss += __shfl_xor(ss, 32);
                if (fq == 0) SSQ[row * 16 + u.pn * 4 + wc] = ss; }
            asm volatile("" ::: "memory"); }
    }
};
struct EpiPe {
    static constexpr bool PERM = true; static constexpr int MID_T = 0; static constexpr bool HAS_BIAS = false;
    bf16_t* PE; const float* SSQ; float* RSTD;
    __device__ __forceinline__ void operator()(const f32x4 (&acc)[2][2][4][2], const Unit& u, int wr, int wc, int fr, int fq) const {
        const int row0 = u.pm * 256 + wr * 64 + fr, col0 = u.pn * 256 + wc * 32 + 8 * fq;
#pragma unroll
        for (int ai = 0; ai < 2; ++ai) {
            f32x4 sv[4][4];
#pragma unroll
            for (int m = 0; m < 4; ++m)
#pragma unroll
                for (int q = 0; q < 4; ++q) sv[m][q] = *(const f32x4*)(SSQ + (size_t)(row0 + ai * 128 + m * 16) * 16 + 4 * q);
#pragma unroll
            for (int m = 0; m < 4; ++m) { const f32x4 st = (sv[m][0] + sv[m][1]) + (sv[m][2] + sv[m][3]);
                RSTD[row0 + ai * 128 + m * 16] = rsqrtf(((st[0] + st[1]) + (st[2] + st[3])) * (1.0f / 1024.0f) + EPS); } }
#pragma unroll
        for (int ai = 0; ai < 2; ++ai)
#pragma unroll
            for (int m = 0; m < 4; ++m) { const size_t row = (size_t)(row0 + ai * 128 + m * 16);
#pragma unroll
                for (int bj = 0; bj < 2; ++bj) { const size_t o = row * 1024 + col0 + bj * 128; const f32x4 a0 = acc[ai][bj][m][0], a1 = acc[ai][bj][m][1];
                    u32x4 w; w.x = pk2(a0[0], a0[1]); w.y = pk2(a0[2], a0[3]); w.z = pk2(a1[0], a1[1]); w.w = pk2(a1[2], a1[3]);
                    *(u32x4*)(PE + o) = w; } }
    }
};
struct EpiFinal {
    static constexpr bool PERM = true; static constexpr int MID_T = 0; static constexpr bool HAS_BIAS = false;
    const bf16_t* PE; const float* RSTD; const float* bias; float* out; const bf16_t* X1B;
    __device__ __forceinline__ void operator()(const f32x4 (&acc)[2][2][4][2], const Unit& u, int wr, int wc, int fr, int fq) const {
        const int row0 = u.pm * 256 + wr * 64 + fr, col0 = u.pn * 256 + wc * 32 + 8 * fq;
        f32x4 bv[2][2];
#pragma unroll
        for (int bj = 0; bj < 2; ++bj)
#pragma unroll
            for (int n = 0; n < 2; ++n) bv[bj][n] = *(const f32x4*)(bias + col0 + bj * 128 + 4 * n);
#pragma unroll
        for (int ai = 0; ai < 2; ++ai) {
            float rs[4]; u32x4 pw[4][2], xw[4][2];
#pragma unroll
            for (int m = 0; m < 4; ++m) { rs[m] = RSTD[row0 + ai * 128 + m * 16];
#pragma unroll
                for (int bj = 0; bj < 2; ++bj) { const size_t o = (size_t)(row0 + ai * 128 + m * 16) * 1024 + col0 + bj * 128;
                    pw[m][bj] = *(const u32x4*)(PE + o); xw[m][bj] = *(const u32x4*)(X1B + o); } }
#pragma unroll
            for (int m = 0; m < 4; ++m)
#pragma unroll
                for (int bj = 0; bj < 2; ++bj) { const size_t o = (size_t)(row0 + ai * 128 + m * 16) * 1024 + col0 + bj * 128;
                    const f32x4 a0 = acc[ai][bj][m][0] * rs[m] + bv[bj][0], a1 = acc[ai][bj][m][1] * rs[m] + bv[bj][1];
                    const u32x4 p = pw[m][bj], xq = xw[m][bj];
                    f32x4 r0, r1;
                    r0[0] = bflo(xq.x) + sigmoidf_(a0[0]) * bflo(p.x); r0[1] = bfhi(xq.x) + sigmoidf_(a0[1]) * bfhi(p.x); r0[2] = bflo(xq.y) + sigmoidf_(a0[2]) * bflo(p.y); r0[3] = bfhi(xq.y) + sigmoidf_(a0[3]) * bfhi(p.y);
                    r1[0] = bflo(xq.z) + sigmoidf_(a1[0]) * bflo(p.z); r1[1] = bfhi(xq.z) + sigmoidf_(a1[1]) * bfhi(p.z); r1[2] = bflo(xq.w) + sigmoidf_(a1[2]) * bflo(p.w); r1[3] = bfhi(xq.w) + sigmoidf_(a1[3]) * bfhi(p.w);
                    *(f32x4*)(out + o) = r0; *(f32x4*)(out + o + 4) = r1; }
            asm volatile("" ::: "memory"); }
    }
};

__device__ __forceinline__ void transpose_item(const float* W, int N, bf16_t* WT, int ldk, int k0, int n0, int drow0, const float* kscale, LAS float* scr, int lane) {
    float tv[32];
#pragma unroll
    for (int i = 0; i < 32; ++i) { const int kk = 2 * i + (lane >> 5); tv[i] = W[(size_t)(k0 + kk) * N + n0 + (lane & 31)]; }
#pragma unroll
    for (int i = 0; i < 32; ++i) { const int kk = 2 * i + (lane >> 5); float v = tv[i]; if (kscale) v *= kscale[k0 + kk]; scr[kk * 33 + (lane & 31)] = v; }
    LDS_WAIT();
    const int c = lane & 7;
#pragma unroll
    for (int j = 0; j < 4; ++j) { const int n = (lane >> 3) + 8 * j; const LAS float* s = scr + (8 * c) * 33 + n;
        u32x4 o; o.x = pk2(s[0 * 33], s[1 * 33]); o.y = pk2(s[2 * 33], s[3 * 33]); o.z = pk2(s[4 * 33], s[5 * 33]); o.w = pk2(s[6 * 33], s[7 * 33]);
        *(u32x4*)(WT + (size_t)(drow0 + n) * ldk + k0 + 8 * c) = o; }
    LDS_WAIT();
}
__device__ __forceinline__ int perm_col(int n) {
    if (n < 1280) return n;
    if (n < 2560) return n + 4864;
    if (n < 7168) return n - 1280;
    if (n < 7680) return n + 256;
    const int gi = n - 7680, which = gi >> 10, c = gi & 1023, gpos = (c >> 7) * 256 + which * 128 + (c & 127);
    return gpos < 256 ? 5888 + gpos : 7936 + (gpos - 256);
}

__device__ __forceinline__ void phase0(const Params& P, LAS unsigned char* L) {
    int tid = threadIdx.x; asm volatile("" : "+v"(tid));
    const int wid = tid >> 6, lane = tid & 63;
    const int gw = blockIdx.x * 8 + wid, NGW = gridDim.x * 8;
    const size_t gt = (size_t)blockIdx.x * 512 + tid, NGT = (size_t)gridDim.x * 512;
    unsigned char* ws = P.ws;
    { bf16_t* HN = (bf16_t*)(ws + OFF_HN);
      f32x4 gn[4];
#pragma unroll
      for (int j = 0; j < 4; ++j) gn[j] = *((const f32x4*)P.norm_mix + lane + 64 * j);
      for (int row = gw; row < MROWS; row += 4 * NGW) {
          f32x4 v[4][4];
#pragma unroll
          for (int r = 0; r < 4; ++r) { const int rr = row + r * NGW < MROWS ? row + r * NGW : row; const f32x4* xr = (const f32x4*)(P.x + (size_t)rr * DM) + lane;
#pragma unroll
              for (int j = 0; j < 4; ++j) v[r][j] = xr[64 * j]; }
#pragma unroll
          for (int r = 0; r < 4; ++r) { float s = 0.f;
#pragma unroll
              for (int j = 0; j < 4; ++j) s += (v[r][j][0] * v[r][j][0] + v[r][j][1] * v[r][j][1]) + (v[r][j][2] * v[r][j][2] + v[r][j][3] * v[r][j][3]);
              const float rstd = rsqrtf(wave_sum(s) * (1.0f / DM) + EPS);
              if (row + r * NGW < MROWS) { u32x2* o8 = (u32x2*)(HN + (size_t)(row + r * NGW) * DM) + lane;
#pragma unroll
                  for (int j = 0; j < 4; ++j) { u32x2 w; w.x = pk2(v[r][j][0] * rstd * gn[j][0], v[r][j][1] * rstd * gn[j][1]); w.y = pk2(v[r][j][2] * rstd * gn[j][2], v[r][j][3] * rstd * gn[j][3]); o8[64 * j] = w; } } }
      } }
    { bf16_t* PB = (bf16_t*)(ws + OFF_PB); const size_t NI = (size_t)MROWS * PLE / 8;
      for (size_t i = gt; i < NI; i += 4 * NGT) { f32x4 av[4], bw[4];
#pragma unroll
          for (int r = 0; r < 4; ++r) { const size_t ii = i + r * NGT < NI ? i + r * NGT : i; av[r] = *((const f32x4*)P.p + 2 * ii); bw[r] = *((const f32x4*)P.p + 2 * ii + 1); }
#pragma unroll
          for (int r = 0; r < 4; ++r) if (i + r * NGT < NI) { u32x4 w; w.x = pk2(av[r][0], av[r][1]); w.y = pk2(av[r][2], av[r][3]); w.z = pk2(bw[r][0], bw[r][1]); w.w = pk2(bw[r][2], bw[r][3]); *((u32x4*)PB + i + r * NGT) = w; } } }
    { LAS float* scr = (LAS float*)(L + wid * 8448);
      constexpr int I0 = 16 * 304, I1 = 20 * 32, I2 = 8 * 32, I3 = 16 * 32, I4 = 16 * 32, I5 = 4 * 32, I6 = 80, I7 = 80;
      constexpr int NIT = I0 + I1 + I2 + I3 + I4 + I5 + I6 + I7;
      for (int it = gw; it < NIT; it += NGW) {
          int r = it;
          if (r < I0) { const int kb = r / 304, nb = r % 304; transpose_item(P.w_in, NIN, (bf16_t*)(ws + OFF_WIN), DM, 64 * kb, 32 * nb, perm_col(32 * nb), nullptr, scr, lane); continue; } r -= I0;
          if (r < I1) { const int kb = r / 32, nb = r % 32; transpose_item(P.w_o_rnn, DM, (bf16_t*)(ws + OFF_WR), 1792, 64 * kb, 32 * nb, 32 * nb, nullptr, scr, lane); continue; } r -= I1;
          if (r < I2) { const int kb = r / 32, nb = r % 32; transpose_item(P.w_o_att, DM, (bf16_t*)(ws + OFF_WR) + DRNN, 1792, 64 * kb, 32 * nb, 32 * nb, nullptr, scr, lane); continue; } r -= I2;
          if (r < I3) { const int kb = r / 32, nb = r % 32; transpose_item(P.w_out, DM, (bf16_t*)(ws + OFF_WOUT), DM, 64 * kb, 32 * nb, 32 * nb, nullptr, scr, lane); continue; } r -= I3;
          if (r < I4) { const int kb = r / 32, nb = r % 32; transpose_item(P.w_ple_gate, DM, (bf16_t*)(ws + OFF_WPG), DM, 64 * kb, 32 * nb, 32 * nb, P.norm_ple, scr, lane); continue; } r -= I4;
          if (r < I5) { const int kb = r / 32, nb = r % 32; transpose_item(P.w_ple, DM, (bf16_t*)(ws + OFF_WPE), PLE, 64 * kb, 32 * nb, 32 * nb, nullptr, scr, lane); continue; } r -= I5;
          if (r < I6) { const int mt = r / 8, q = r % 8, kb = q / 4, nb = q % 4; transpose_item(P.w_rg_a + (size_t)mt * 16384, 128, (bf16_t*)(ws + OFF_WGA) + (size_t)mt * 16384, 128, 64 * kb, 32 * nb, 32 * nb, nullptr, scr, lane); continue; } r -= I6;
          { const int mt = r / 8, q = r % 8, kb = q / 4, nb = q % 4; transpose_item(P.w_rg_x + (size_t)mt * 16384, 128, (bf16_t*)(ws + OFF_WGX) + (size_t)mt * 16384, 128, 64 * kb, 32 * nb, 32 * nb, nullptr, scr, lane); }
      } }
    { float* BIN = (float*)(ws + OFF_BIN);
      for (size_t i = gt; i < (size_t)NIN; i += NGT) BIN[perm_col((int)i)] = P.b_in[i];
      float* RC = (float*)(ws + OFF_ROPE); float* RS = RC + SEQ * 64;
      for (size_t i = gt; i < (size_t)SEQ * 64; i += NGT) { const int pos = (int)(i >> 6), j = (int)(i & 63);
          const float inv_freq = (float)exp2(-(double)j * (13.287712379549449 / 64.0));
          const float angf = (float)pos * inv_freq; const double ang = (double)angf; const double k = rint(ang * 0.15915494309189535);
          const float rr = (float)(ang - k * 6.283185307179586);
          RC[i] = __cosf(rr); RS[i] = __sinf(rr); } }
}

typedef float f32x2 __attribute__((ext_vector_type(2)));
__device__ __forceinline__ void norm_rope(u32x4 (&raw)[4], const LAS float* gain_fq, const f32x2 (&cs)[2][4], const f32x2 (&sn)[2][4], float scale) {
    f32x2 v[4][4]; f32x2 ss2 = (f32x2){0.f, 0.f};
#pragma unroll
    for (int kk = 0; kk < 4; ++kk)
#pragma unroll
        for (int i = 0; i < 4; ++i) { const unsigned w = raw[kk][i]; v[kk][i] = (f32x2){bflo(w), bfhi(w)}; ss2 = v[kk][i] * v[kk][i] + ss2; }
    float ss = ss2.x + ss2.y;
    ss += __shfl_xor(ss, 16); ss += __shfl_xor(ss, 32);
    const float rstd = rsqrtf(ss * (1.0f / 128.0f) + EPS) * scale;
#pragma unroll
    for (int kk = 0; kk < 4; ++kk) { const f32x4 g0 = *(const LAS f32x4*)(gain_fq + kk * 32), g1 = *(const LAS f32x4*)(gain_fq + kk * 32 + 4);
        v[kk][0] *= (f32x2){g0[0], g0[1]}; v[kk][1] *= (f32x2){g0[2], g0[3]}; v[kk][2] *= (f32x2){g1[0], g1[1]}; v[kk][3] *= (f32x2){g1[2], g1[3]}; }
#pragma unroll
    for (int kk = 0; kk < 2; ++kk)
#pragma unroll
        for (int i = 0; i < 4; ++i) { const f32x2 cc = cs[kk][i] * rstd, sc = sn[kk][i] * rstd; const f32x2 t1 = v[kk][i], t2 = v[kk + 2][i];
            v[kk][i] = t1 * cc - t2 * sc; v[kk + 2][i] = t2 * cc + t1 * sc; }
#pragma unroll
    for (int kk = 0; kk < 4; ++kk)
#pragma unroll
        for (int i = 0; i < 4; ++i) raw[kk][i] = pk2(v[kk][i].x, v[kk][i].y);
}

__device__ __forceinline__ void attn_seq(const Params& P, LAS unsigned char* L, int u, unsigned* ctr, LAS int* bc) {
    int nxt = 0;
    int tid = threadIdx.x; asm volatile("" : "+v"(tid));
    const int wid = tid >> 6, lane = tid & 63, fr = lane & 15, fq = lane >> 4;
    int g, b, h, c, nblk;
    if (u < 64) { g = 0; b = u >> 2; h = u & 3; c = 0; nblk = 16; }
    else if (u < 320) { const int r = u - 64; g = 1; b = r >> 4; h = (r >> 2) & 3; c = r & 3; nblk = 4; }
    else { const int r = u - 320; g = 2; b = r >> 6; h = (r >> 4) & 3; c = r & 15; nblk = 1; }
    const int dil = 1 << (2 * g);
    const bf16_t* QKV = (const bf16_t*)(P.ws + OFF_R);
    const int qcol = g * 1536 + h * 128;
    const size_t brow = (size_t)b * SEQ;
    const LAS float* gl = (const LAS float*)(L + GAIN_OFF) + g * 256;
    const LAS float* kgain = gl + fq * 8; const LAS float* qgain = gl + 128 + fq * 8;
    f32x2 frev[2][4];
#pragma unroll
    for (int kk = 0; kk < 2; ++kk)
#pragma unroll
        for (int i = 0; i < 4; ++i) { const float j0 = (float)(kk * 32 + fq * 8 + 2 * i);
            frev[kk][i] = (f32x2){__builtin_amdgcn_exp2f(-j0 * (13.287712379549449f / 64.0f)) * 0.15915494309189535f, __builtin_amdgcn_exp2f(-(j0 + 1.0f) * (13.287712379549449f / 64.0f)) * 0.15915494309189535f}; }
    const int dg = (lane >> 4) + 4 * (wid & 3), kg = (lane & 15) + 16 * (wid >> 2);
    u32x4 qraw[4], kraw[4], vraw[4];
    { const bf16_t* qp = QKV + (brow + (size_t)(16 * wid + fr) * dil + c) * QKVW + qcol + fq * 8;
#pragma unroll
      for (int kk = 0; kk < 4; ++kk) { qraw[kk] = *(const u32x4*)(qp + kk * 32); kraw[kk] = *(const u32x4*)(qp + 512 + kk * 32); }
#pragma unroll
      for (int i = 0; i < 4; ++i) vraw[i] = *(const u32x4*)(QKV + (brow + (size_t)(4 * kg + i) * dil + c) * QKVW + qcol + 1024 + dg * 8); }
    for (int n = 0; n < nblk; ++n) {
        const int slot = n & 1, kx = slot ? 0 : 8;
        const int sq = (128 * n + 16 * wid + fr) * dil + c;
        f32x2 cs[2][4], sn[2][4];
#pragma unroll
        for (int kk = 0; kk < 2; ++kk)
#pragma unroll
            for (int i = 0; i < 4; ++i) { const f32x2 rv = frev[kk][i] * (float)sq; const float r0 = __builtin_amdgcn_fractf(rv.x), r1 = __builtin_amdgcn_fractf(rv.y);
                cs[kk][i] = (f32x2){__builtin_amdgcn_cosf(r0), __builtin_amdgcn_cosf(r1)}; sn[kk][i] = (f32x2){__builtin_amdgcn_sinf(r0), __builtin_amdgcn_sinf(r1)}; }
        norm_rope(kraw, kgain, cs, sn, 1.0f);
#pragma unroll
        for (int kk = 0; kk < 4; ++kk) *(LAS u32x4*)(L + (slot * 128 + 16 * wid + fr) * KS_STRIDE + (kk * 32 + fq * 8) * 2) = kraw[kk];
#pragma unroll
        for (int d = 0; d < 8; ++d) { u32x2 o;
            o.x = __builtin_amdgcn_perm(vraw[1][d >> 1], vraw[0][d >> 1], (d & 1) ? 0x07060302u : 0x05040100u);
            o.y = __builtin_amdgcn_perm(vraw[3][d >> 1], vraw[2][d >> 1], (d & 1) ? 0x07060302u : 0x05040100u);
            *(LAS u32x2*)(L + VT_OFF + (8 * dg + d) * VT_STRIDE + (slot * 128 + 4 * kg) * 2) = o;
            if (n == 0) *(LAS u32x2*)(L + VT_OFF + (8 * dg + d) * VT_STRIDE + ((slot ^ 1) * 128 + 4 * kg) * 2) = (u32x2){0u, 0u}; }
        norm_rope(qraw, qgain, cs, sn, 0.08838834764831845f * 1.4426950408889634f);
        bf16x8 qf[4];
#pragma unroll
        for (int kk = 0; kk < 4; ++kk) qf[kk] = __builtin_bit_cast(bf16x8, qraw[kk]);
        asm volatile("s_waitcnt lgkmcnt(0)" ::: "memory"); __builtin_amdgcn_s_barrier(); asm volatile("" ::: "memory");
        if (n + 1 == nblk && threadIdx.x == 0) nxt = (int)atomicAdd(ctr, 1u);
        if (n + 1 < nblk) { const bf16_t* qp = QKV + (brow + (size_t)(128 * (n + 1) + 16 * wid + fr) * dil + c) * QKVW + qcol + fq * 8;
#pragma unroll
            for (int kk = 0; kk < 4; ++kk) { qraw[kk] = *(const u32x4*)(qp + kk * 32); kraw[kk] = *(const u32x4*)(qp + 512 + kk * 32); }
#pragma unroll
            for (int i = 0; i < 4; ++i) vraw[i] = *(const u32x4*)(QKV + (brow + (size_t)(128 * (n + 1) + 4 * kg + i) * dil + c) * QKVW + qcol + 1024 + dg * 8); }
        f32x4 sacc[10];
#pragma unroll
        for (int p = 0; p < 9; ++p) { sacc[p] = (f32x4){0.f, 0.f, 0.f, 0.f}; const int kt = wid + p;
            if (n > 0 || kt >= 8) { const int ktp = kt ^ kx;
#pragma unroll
                for (int kk = 0; kk < 4; ++kk) { const bf16x8 a = *(const LAS bf16x8*)(L + (16 * ktp + fr) * KS_STRIDE + (kk * 32 + fq * 8) * 2);
                    sacc[p] = __builtin_amdgcn_mfma_f32_16x16x32_bf16(a, qf[kk], sacc[p], 0, 0, 0); } } }
        float mx = -INFINITY;
#pragma unroll
        for (int p = 0; p < 9; ++p) { const bool tile_ok = (n > 0) || (wid + p >= 8);
#pragma unroll
            for (int jj = 0; jj < 4; ++jj) { const int e = 4 * fq + jj - fr;
                const bool valid = tile_ok && (p == 0 ? e >= 0 : (p == 8 ? e <= 0 : true));
                sacc[p][jj] = valid ? sacc[p][jj] : -INFINITY; mx = fmaxf(mx, sacc[p][jj]); } }
        mx = fmaxf(mx, __shfl_xor(mx, 16)); mx = fmaxf(mx, __shfl_xor(mx, 32));
        float den = 0.f;
#pragma unroll
        for (int p = 0; p < 9; ++p)
#pragma unroll
            for (int jj = 0; jj < 4; ++jj) { const float e = __builtin_amdgcn_exp2f(sacc[p][jj] - mx); sacc[p][jj] = e; den += e; }
        sacc[9] = (f32x4){0.f, 0.f, 0.f, 0.f};
        den += __shfl_xor(den, 16); den += __shfl_xor(den, 32);
        f32x4 oacc[8];
#pragma unroll
        for (int dt = 0; dt < 8; ++dt) oacc[dt] = (f32x4){0.f, 0.f, 0.f, 0.f};
#pragma unroll
        for (int pp = 0; pp < 5; ++pp) { const int kt0 = wid + 2 * pp, kt1 = (kt0 + 1 < 16) ? kt0 + 1 : 15;
            if (n > 0 || kt0 + 1 >= 8) { const int kp0 = kt0 ^ kx, kp1 = kt1 ^ kx;
                u32x4 pw; pw.x = pk2(sacc[2 * pp][0], sacc[2 * pp][1]); pw.y = pk2(sacc[2 * pp][2], sacc[2 * pp][3]); pw.z = pk2(sacc[2 * pp + 1][0], sacc[2 * pp + 1][1]); pw.w = pk2(sacc[2 * pp + 1][2], sacc[2 * pp + 1][3]);
                const bf16x8 pb = __builtin_bit_cast(bf16x8, pw);
#pragma unroll
                for (int dt = 0; dt < 8; ++dt) { const LAS unsigned char* vrow = L + VT_OFF + (16 * dt + fr) * VT_STRIDE + (4 * fq) * 2;
                    const u32x2 lo = *(const LAS u32x2*)(vrow + kp0 * 32), hi = *(const LAS u32x2*)(vrow + kp1 * 32);
                    u32x4 aw; aw.x = lo.x; aw.y = lo.y; aw.z = hi.x; aw.w = hi.y;
                    oacc[dt] = __builtin_amdgcn_mfma_f32_16x16x32_bf16(__builtin_bit_cast(bf16x8, aw), pb, oacc[dt], 0, 0, 0); } } }
        if (n + 1 == nblk && threadIdx.x == 0) *bc = nxt;
        { const float inv = 1.0f / den; const size_t row = brow + sq;
          bf16_t* OG = (bf16_t*)P.out + ((size_t)g * MROWS + row) * ATTW + h * 128 + 4 * fq;
#pragma unroll
          for (int dt = 0; dt < 8; ++dt) { u32x2 w; w.x = pk2(oacc[dt][0] * inv, oacc[dt][1] * inv); w.y = pk2(oacc[dt][2] * inv, oacc[dt][3] * inv); *(u32x2*)(OG + 16 * dt) = w; }
          if (fq == 0) ((float*)(P.ws + OFF_LSE))[((size_t)g * MROWS + row) * 4 + h] = (mx + __log2f(den)) * 0.6931471805599453f; }
        asm volatile("s_waitcnt lgkmcnt(0)" ::: "memory"); __builtin_amdgcn_s_barrier(); asm volatile("" ::: "memory");
    }
}

constexpr int LXC = 128 * XC_STRIDE;
constexpr int HS_OFF = 2 * LXC, HALO_OFF = 4 * LXC;
__device__ __forceinline__ void lru_seq(const Params& P, LAS unsigned char* L, int it, unsigned* ctr, LAS int* qnext) {
    int nxt = 0;
    int tid = threadIdx.x; asm volatile("" : "+v"(tid));
    const int wid = tid >> 6, lane = tid & 63, fr = lane & 15, fq = lane >> 4;
    const int b = it / 10, n = it % 10;
    bf16_t* XR = (bf16_t*)(P.ws + OFF_XR);
    const int cg8 = tid & 15, tg = tid >> 4, ch0 = 128 * n + 8 * cg8;
    f32x2 wk[4][4], bc[4];
#pragma unroll
    for (int k = 0; k < 4; ++k) { const f32x4 a = *(const f32x4*)(P.conv_w + k * DRNN + ch0), bq = *(const f32x4*)(P.conv_w + k * DRNN + ch0 + 4);
        wk[k][0] = (f32x2){a[0], a[1]}; wk[k][1] = (f32x2){a[2], a[3]}; wk[k][2] = (f32x2){bq[0], bq[1]}; wk[k][3] = (f32x2){bq[2], bq[3]}; }
    { const f32x4 a = *(const f32x4*)(P.conv_b + ch0), bq = *(const f32x4*)(P.conv_b + ch0 + 4);
      bc[0] = (f32x2){a[0], a[1]}; bc[1] = (f32x2){a[2], a[3]}; bc[2] = (f32x2){bq[0], bq[1]}; bc[3] = (f32x2){bq[2], bq[3]}; }
    const int ch = 128 * n + 16 * wid + fr;
    bf16x8 bfa[4], bfx[4];
    { const bf16_t* WA = (const bf16_t*)(P.ws + OFF_WGA) + (size_t)n * 16384 + (16 * wid + fr) * 128 + fq * 8;
      const bf16_t* WX = (const bf16_t*)(P.ws + OFF_WGX) + (size_t)n * 16384 + (16 * wid + fr) * 128 + fq * 8;
#pragma unroll
      for (int kk = 0; kk < 4; ++kk) { bfa[kk] = __builtin_bit_cast(bf16x8, *(const u32x4*)(WA + kk * 32)); bfx[kk] = __builtin_bit_cast(bf16x8, *(const u32x4*)(WX + kk * 32)); } }
    const float LOG2E = 1.4426950408889634f;
    const float ba2 = -P.b_rg_a[ch] * LOG2E, bx2 = -P.b_rg_x[ch] * LOG2E, cs = -8.0f * LOG2E * log1pf(__expf(-P.lam[ch]));
    float hc = 0.f;
    u32x4 xw[7];
    const bf16_t* xrow = XR + ((size_t)b * SEQ + 4 * tg - 3) * DRNN + ch0;
#pragma unroll
    for (int ri = 0; ri < 7; ++ri) xw[ri] = (tg == 0 && ri < 3) ? (u32x4){0u, 0u, 0u, 0u} : *(const u32x4*)(xrow + (size_t)ri * DRNN);
    auto stepA = [&](int ca) {
        if (tg == 0 && ca > 0) {
#pragma unroll
            for (int ri = 0; ri < 3; ++ri) xw[ri] = *(const LAS u32x4*)(L + HALO_OFF + ((ca & 1) ^ 1) * 768 + ri * 256 + cg8 * 16); }
        if (tg == 31) {
#pragma unroll
            for (int ri = 4; ri < 7; ++ri) *(LAS u32x4*)(L + HALO_OFF + (ca & 1) * 768 + (ri - 4) * 256 + cg8 * 16) = xw[ri]; }
        f32x2 xin[7][4];
#pragma unroll
        for (int ri = 0; ri < 7; ++ri)
#pragma unroll
            for (int i = 0; i < 4; ++i) xin[ri][i] = (f32x2){bflo(xw[ri][i]), bfhi(xw[ri][i])};
#pragma unroll
        for (int o = 0; o < 4; ++o) { u32x4 w;
#pragma unroll
            for (int i = 0; i < 4; ++i) { const f32x2 y = wk[3][i] * xin[o + 3][i] + (wk[2][i] * xin[o + 2][i] + (wk[1][i] * xin[o + 1][i] + (wk[0][i] * xin[o][i] + bc[i]))); w[i] = pk2(y.x, y.y); }
            *(LAS u32x4*)(L + (ca & 1) * LXC + (4 * tg + o) * XC_STRIDE + cg8 * 16) = w; }
    };
    stepA(0);
    __syncthreads();
    for (int ck = 0; ck < 16; ++ck) {
        const int t0 = ck * 128;
        LAS unsigned char* Xc = L + (ck & 1) * LXC; LAS unsigned char* Hs = L + HS_OFF + (ck & 1) * LXC;
        if (ck == 15 && threadIdx.x == 0) nxt = (int)atomicAdd(ctr, 1u);
        if (ck < 15) {
#pragma unroll
            for (int ri = 0; ri < 7; ++ri) if (!(tg == 0 && ri < 3)) xw[ri] = *(const u32x4*)(xrow + (size_t)(t0 + 128 + ri) * DRNN); }
#pragma unroll
        for (int m = 0; m < 8; ++m) {
            f32x4 aa = (f32x4){0.f, 0.f, 0.f, 0.f}, ax = (f32x4){0.f, 0.f, 0.f, 0.f};
#pragma unroll
            for (int kk = 0; kk < 4; ++kk) { const bf16x8 a = *(const LAS bf16x8*)(Xc + (16 * m + fr) * XC_STRIDE + (kk * 32 + fq * 8) * 2);
                aa = __builtin_amdgcn_mfma_f32_16x16x32_bf16(a, bfa[kk], aa, 0, 0, 0); ax = __builtin_amdgcn_mfma_f32_16x16x32_bf16(a, bfx[kk], ax, 0, 0, 0); }
            float av[4], uv[4];
#pragma unroll
            for (int jj = 0; jj < 4; ++jj) { const int tl = 16 * m + 4 * fq + jj;
                const float rg = __builtin_amdgcn_rcpf(1.0f + __builtin_amdgcn_exp2f(fmaf(aa[jj], -LOG2E, ba2)));
                const float ig = __builtin_amdgcn_rcpf(1.0f + __builtin_amdgcn_exp2f(fmaf(ax[jj], -LOG2E, bx2)));
                const float a = __builtin_amdgcn_exp2f(cs * rg);
                float mult = __builtin_amdgcn_sqrtf(fmaf(-a, a, 1.0f));
                if (m == 0 && jj == 0) mult = (ck == 0 && fq == 0) ? 1.0f : mult;
                const float xcv = bf2f(*(const LAS bf16_t*)(Xc + tl * XC_STRIDE + (16 * wid + fr) * 2));
                av[jj] = a; uv[jj] = mult * ig * xcv; }
            float AL = av[0], HL = uv[0];
#pragma unroll
            for (int jj = 1; jj < 4; ++jj) { HL = fmaf(av[jj], HL, uv[jj]); AL *= av[jj]; }
            const float A0 = __shfl(AL, fr), H0 = __shfl(HL, fr), A1 = __shfl(AL, fr + 16), H1 = __shfl(HL, fr + 16), A2 = __shfl(AL, fr + 32), H2 = __shfl(HL, fr + 32), A3 = __shfl(AL, fr + 48), H3 = __shfl(HL, fr + 48);
            const float h0 = hc, h1 = fmaf(A0, h0, H0), h2 = fmaf(A1, h1, H1), h3 = fmaf(A2, h2, H2), he = fmaf(A3, h3, H3);
            float hh = fq == 0 ? h0 : (fq == 1 ? h1 : (fq == 2 ? h2 : h3));
#pragma unroll
            for (int jj = 0; jj < 4; ++jj) { hh = fmaf(av[jj], hh, uv[jj]);
                *(LAS bf16_t*)(Hs + (16 * m + 4 * fq + jj) * XC_STRIDE + (16 * wid + fr) * 2) = (bf16_t)(pk2(hh, 0.f) & 0xffffu); }
            hc = he;
        }
        if (ck < 15) stepA(ck + 1);
        if (ck == 15 && threadIdx.x == 0) *qnext = nxt;
        __syncthreads();
#pragma unroll
        for (int o = 0; o < 4; ++o) *(u32x4*)(XR + ((size_t)b * SEQ + t0 + 4 * tg + o) * DRNN + ch0) = *(const LAS u32x4*)(Hs + (4 * tg + o) * XC_STRIDE + cg8 * 16);
    }
    __syncthreads();
}

#ifndef REPEAT_MASK
#define REPEAT_MASK 0
#endif
#define NREP(bit) (((REPEAT_MASK >> (bit)) & 1) ? 2 : 1)
__global__ void __launch_bounds__(512, 2) fwd_megakernel(Params P) {
    extern __shared__ __attribute__((aligned(16))) unsigned char shm[];
    LAS unsigned char* L = (LAS unsigned char*)shm;
    cg::grid_group grid = cg::this_grid();
    unsigned char* ws = P.ws;
    const int G = (int)gridDim.x, c = (int)blockIdx.x;
    pg8::StaticOrder S;
    volatile LAS unsigned* xst = (volatile LAS unsigned*)(L + LDS_BYTES - 8);
    if (threadIdx.x == 0) { xst[0] = 0u; xst[1] = 0u; }
    __syncthreads();
    if (ws == nullptr) grid.sync();
    const XcdBarrier xb = xcd_barrier_post((unsigned*)(ws + OFF_BAR), xst);
    for (int rep = 0; rep < NREP(0); ++rep) phase0(P, L);
    xcd_barrier(xb);
    for (int rep = 0; rep < NREP(1); ++rep)
    { pg8::Gemm g{(const bf16_t*)(ws + OFF_HN), (const bf16_t*)(ws + OFF_WIN), MROWS, NA, DM}; S.init(MROWS, NA, G, c);
      EpiProj<0> E{(const float*)(ws + OFF_BIN), ws, nullptr};
      pg8::gemm_phase(L, g, S, E); }
    xcd_barrier(xb);
    {
        unsigned* ctr = (unsigned*)(ws + OFF_CTR);
        LAS int* bc = (LAS int*)(L + LDS_BYTES - 16);
        { LAS float* gl = (LAS float*)(L + GAIN_OFF);
          for (int i = threadIdx.x; i < 768; i += 512) { const int gq = i >> 8, j = i & 255; gl[i] = j < 128 ? P.k_norm[gq * 128 + j] : P.q_norm[gq * 128 + j - 128]; } }
        if (threadIdx.x == 0) *bc = (int)atomicAdd(ctr, 1u);
        __syncthreads();
        for (;;) {
            const int it = *bc;
            if (it >= 160 + 1344) break;
            if (it < 64) attn_seq(P, L, it, ctr, bc); else if (it < 224) lru_seq(P, L, it - 64, ctr, bc); else attn_seq(P, L, it - 160, ctr, bc);
        }
        __syncthreads();
    }
    for (int rep = 0; rep < NREP(3); ++rep)
    { pg8::Gemm g{(const bf16_t*)(ws + OFF_HN), (const bf16_t*)(ws + OFF_WIN) + (size_t)NA * DM, MROWS, NB, DM}; S.init(MROWS, NB, G, c);
      EpiProj<1> E{(const float*)(ws + OFF_BIN) + NA, ws, (const void*)P.out};
      pg8::gemm_phase(L, g, S, E, rep == 0 ? &xb : nullptr); }
    for (int rep = 0; rep < NREP(4); ++rep)
    { pg8::Gemm g{(const bf16_t*)(ws + OFF_ZR), (const bf16_t*)(ws + OFF_WR), MROWS, DM, 1792}; S.init(MROWS, DM, G, c);
      EpiMergeFused E{(const bf16_t*)(ws + OFF_G), (bf16_t*)(ws + OFF_HN), (const bf16_t*)(ws + OFF_GX)};
      pg8::gemm_phase(L, g, S, E, rep == 0 ? &xb : nullptr); }
    for (int rep = 0; rep < NREP(5); ++rep)
    { pg8::Gemm g{(const bf16_t*)(ws + OFF_HN), (const bf16_t*)(ws + OFF_WOUT), MROWS, DM, DM}; S.init(MROWS, DM, G, c);
      EpiX1 E{P.x, P.out, (bf16_t*)(ws + OFF_XR), (float*)(ws + OFF_SSQ)};
      pg8::gemm_phase(L, g, S, E, rep == 0 ? &xb : nullptr); }
    for (int rep = 0; rep < NREP(6); ++rep) {
    { pg8::Gemm g{(const bf16_t*)(ws + OFF_PB), (const bf16_t*)(ws + OFF_WPE), MROWS, DM, PLE}; S.init(MROWS, DM, G, c);
      EpiPe E{(bf16_t*)(ws + OFF_G), (const float*)(ws + OFF_SSQ), (float*)(ws + OFF_TOT)};
      pg8::gemm_phase(L, g, S, E, rep == 0 ? &xb : nullptr); }
    { pg8::Gemm g{(const bf16_t*)(ws + OFF_XR), (const bf16_t*)(ws + OFF_WPG), MROWS, DM, DM}; S.init(MROWS, DM, G, c);
      EpiFinal E{(const bf16_t*)(ws + OFF_G), (const float*)(ws + OFF_TOT), P.b_ple_gate, P.out, (const bf16_t*)(ws + OFF_XR)};
      pg8::gemm_phase(L, g, S, E); } }
}

extern "C" void kernel_launch(void* const* d_in, const int* in_sizes, int n_in, void* d_out, int out_size, void* d_ws, size_t ws_size, hipStream_t stream) {
    static int grid_blocks = 0;
    if (grid_blocks == 0) {
        if (n_in != 21 || in_sizes[0] != MROWS * DM || out_size != MROWS * DM || ws_size < WS_END) { fprintf(stderr, "kernel_launch: unexpected shapes / workspace (n_in %d, ws %zu, need %zu)\n", n_in, ws_size, (size_t)WS_END); grid_blocks = -1; return; }
        int dev = 0, cus = 0, per_cu = 0;
        (void)hipGetDevice(&dev);
        (void)hipDeviceGetAttribute(&cus, hipDeviceAttributeMultiprocessorCount, dev);
        if (hipFuncSetAttribute((const void*)fwd_megakernel, hipFuncAttributeMaxDynamicSharedMemorySize, LDS_BYTES) != hipSuccess) { fprintf(stderr, "kernel_launch: hipFuncSetAttribute failed\n"); grid_blocks = -1; return; }
        if (hipOccupancyMaxActiveBlocksPerMultiprocessor(&per_cu, (const void*)fwd_megakernel, 512, LDS_BYTES) != hipSuccess || per_cu < 1) { fprintf(stderr, "kernel_launch: occupancy query failed (%d)\n", per_cu); per_cu = 1; (void)hipGetLastError(); }
        grid_blocks = cus * 1;
    }
    if (grid_blocks < 0) return;
    Params P{};
    P.x = (const float*)d_in[0]; P.p = (const float*)d_in[1]; P.norm_mix = (const float*)d_in[2]; P.w_in = (const float*)d_in[3]; P.b_in = (const float*)d_in[4];
    P.conv_w = (const float*)d_in[5]; P.conv_b = (const float*)d_in[6]; P.w_rg_a = (const float*)d_in[7]; P.b_rg_a = (const float*)d_in[8]; P.w_rg_x = (const float*)d_in[9]; P.b_rg_x = (const float*)d_in[10];
    P.lam = (const float*)d_in[11]; P.q_norm = (const float*)d_in[12]; P.k_norm = (const float*)d_in[13]; P.w_o_rnn = (const float*)d_in[14]; P.w_o_att = (const float*)d_in[15]; P.w_out = (const float*)d_in[16];
    P.norm_ple = (const float*)d_in[17]; P.w_ple_gate = (const float*)d_in[18]; P.b_ple_gate = (const float*)d_in[19]; P.w_ple = (const float*)d_in[20];
    P.out = (float*)d_out; P.ws = (unsigned char*)d_ws;
    if (hipMemsetAsync((char*)d_ws + OFF_CTR, 0, OFF_HN - OFF_CTR, stream) != hipSuccess) { fprintf(stderr, "kernel_launch: hipMemsetAsync of the barrier / queue words failed\n"); return; }
    void* args[] = {&P};
    hipError_t e = hipLaunchCooperativeKernel((const void*)fwd_megakernel, dim3(grid_blocks), dim3(512), args, LDS_BYTES, stream);
    if (e != hipSuccess) fprintf(stderr, "cooperative launch failed: %s (grid %d)\n", hipGetErrorString(e), grid_blocks);
}
```
